# Optimizing an MI355X kernel written in HIP

```python
import math
import jax
import jax.numpy as jnp
from jax import lax
import numpy as np

D_MODEL = 1024
BATCH = 8
SEQ = 8192
DEPTH = 2

HEAD_DIM = 64
GRID_W = 64
N_MEM = 256
NA_HEADS = 6
NA_WIN_ROWS = 8
NA_WIN_COLS = 16
ML_HEADS = 4
ML_CHUNK = 64
GDN_HEADS = 6
GDN_CHUNK = 64
CONV_K = 5
N_DIR = 2
XA_HEADS = 4
XA_HEAD_DIM = D_MODEL // XA_HEADS
D_FF = 4 * D_MODEL
NA_WIDTH = NA_HEADS * HEAD_DIM
ML_WIDTH = ML_HEADS * HEAD_DIM
GDN_WIDTH = GDN_HEADS * HEAD_DIM
D_MIX = NA_WIDTH + ML_WIDTH + GDN_WIDTH
EPS = 1e-6
IN_SIZES = (NA_WIDTH, NA_WIDTH, NA_WIDTH,
            ML_WIDTH, ML_WIDTH, ML_WIDTH, ML_WIDTH, N_DIR * ML_HEADS, N_DIR * ML_HEADS,
            GDN_WIDTH, GDN_WIDTH, GDN_WIDTH, GDN_WIDTH, N_DIR * GDN_HEADS, N_DIR * GDN_HEADS)
IN_OFFSETS = tuple(int(o) for o in np.cumsum(IN_SIZES)[:-1])
P_IN = int(sum(IN_SIZES))

kernel_name = 'hybrid_na_mlstm_gdn_encoder'


def rmsnorm(x, w):
    xf = x.astype(jnp.float32)
    y = xf * lax.rsqrt(jnp.mean(xf * xf, axis=-1, keepdims=True) + EPS)
    return (y * w.astype(jnp.float32)).astype(x.dtype)


def head_rms(t):
    return t * lax.rsqrt(jnp.mean(t * t, axis=-1, keepdims=True) + EPS)


def l2norm(t):
    return t * lax.rsqrt(jnp.sum(t * t, axis=-1, keepdims=True) + EPS)


def neighbourhood_attention(q, k, v, rel_bias):
    b, s, h, dh = q.shape
    rows = s // GRID_W
    wr = min(NA_WIN_ROWS, rows)
    wc = NA_WIN_COLS
    qg = (q * dh ** -0.5).reshape(b, rows, GRID_W, h, dh)
    kg = k.reshape(b, rows, GRID_W, h, dh)
    vg = v.reshape(b, rows, GRID_W, h, dh)
    cols = jnp.arange(GRID_W)
    col_idx = jnp.clip(cols - wc // 2, 0, GRID_W - wc)[:, None] + jnp.arange(wc)[None, :]
    dc = col_idx - cols[:, None] + (NA_WIN_COLS - 1)

    def row_block(args):
        q_r, r = args
        r0 = jnp.clip(r - wr // 2, 0, rows - wr)
        k_win = lax.dynamic_slice_in_dim(kg, r0, wr, axis=1)[:, :, col_idx]
        v_win = lax.dynamic_slice_in_dim(vg, r0, wr, axis=1)[:, :, col_idx]
        dr = r0 + jnp.arange(wr) - r + (NA_WIN_ROWS - 1)
        bias = rel_bias[:, dr[None, :, None], dc[:, None, :]]
        logits = jnp.einsum('bqhd,brqchd->bhqrc', q_r, k_win).astype(jnp.float32) + bias.astype(jnp.float32)
        p = jax.nn.softmax(logits.reshape(b, h, GRID_W, wr * wc), axis=-1).reshape(logits.shape)
        return jnp.einsum('bhqrc,brqchd->bqhd', p.astype(v.dtype), v_win)

    out = lax.map(row_block, (jnp.moveaxis(qg, 1, 0), jnp.arange(rows)))
    return jnp.moveaxis(out, 0, 1).reshape(b, s, h * dh)


def mlstm_direction(q, k, v, ig, f_pre):
    b, h, s, d = q.shape
    L = ML_CHUNK
    nc = s // L
    q = q.reshape(b, h, nc, L, d)
    k = k.reshape(b, h, nc, L, d) * d ** -0.5
    v = v.reshape(b, h, nc, L, d)
    ig = ig.reshape(b, h, nc, L)
    bcum = jnp.cumsum(jax.nn.log_sigmoid(f_pre).reshape(b, h, nc, L), axis=-1)
    b_last = bcum[..., -1]
    w = b_last[..., None] - bcum + ig
    m_loc = jnp.max(w, axis=-1)
    wexp = jnp.exp(w - m_loc[..., None])
    c_loc = jnp.einsum('bhnl,bhnld,bhnle->nbhde', wexp, k, v)
    n_loc = jnp.einsum('bhnl,bhnld->nbhd', wexp, k)

    def step(carry, xs):
        c, n, m = carry
        c_l, n_l, m_l, bl = xs
        m_new = jnp.maximum(bl + m, m_l)
        a = jnp.exp(bl + m - m_new)
        g = jnp.exp(m_l - m_new)
        c_new = a[..., None, None] * c + g[..., None, None] * c_l
        n_new = a[..., None] * n + g[..., None] * n_l
        return (c_new, n_new, m_new), (c, n, m)

    init = (jnp.zeros((b, h, d, d), jnp.float32), jnp.zeros((b, h, d), jnp.float32), jnp.zeros((b, h), jnp.float32))
    _, (c_prev, n_prev, m_prev) = lax.scan(
        step, init, (c_loc, n_loc, jnp.moveaxis(m_loc, -1, 0), jnp.moveaxis(b_last, -1, 0)))
    c_prev = jnp.moveaxis(c_prev, 0, 2)
    n_prev = jnp.moveaxis(n_prev, 0, 2)
    m_prev = jnp.moveaxis(m_prev, 0, -1)
    causal = jnp.tril(jnp.ones((L, L), dtype=bool))
    dmat = jnp.where(causal, bcum[..., :, None] - bcum[..., None, :] + ig[..., None, :], -jnp.inf)
    inter = bcum + m_prev[..., None]
    m_t = jnp.maximum(jnp.max(dmat, axis=-1), inter)
    s_intra = jnp.einsum('bhnld,bhnsd->bhnls', q, k) * jnp.exp(dmat - m_t[..., None])
    a_inter = jnp.exp(inter - m_t)
    num = a_inter[..., None] * jnp.einsum('bhnld,bhnde->bhnle', q, c_prev) + jnp.einsum('bhnls,bhnse->bhnle', s_intra, v)
    den = a_inter * jnp.einsum('bhnld,bhnd->bhnl', q, n_prev) + jnp.sum(s_intra, axis=-1)
    out = num / jnp.maximum(jnp.abs(den), jnp.exp(-m_t))[..., None]
    return out.reshape(b, h, s, d)


def mlstm_mixer(q, k, v, o_pre, i_pre, f_pre, i_bias, f_bias, norm_w):
    b, s, _ = q.shape

    def heads(t):
        return t.reshape(b, s, ML_HEADS, HEAD_DIM).transpose(0, 2, 1, 3).astype(jnp.float32)

    qh, kh, vh = heads(q), heads(k), heads(v)
    ig = (i_pre.reshape(b, s, N_DIR, ML_HEADS).astype(jnp.float32) + i_bias.astype(jnp.float32)).transpose(2, 0, 3, 1)
    fg = (f_pre.reshape(b, s, N_DIR, ML_HEADS).astype(jnp.float32) + f_bias.astype(jnp.float32)).transpose(2, 0, 3, 1)
    h_fwd = mlstm_direction(qh, kh, vh, ig[0], fg[0])
    h_bwd = jnp.flip(mlstm_direction(jnp.flip(qh, 2), jnp.flip(kh, 2), jnp.flip(vh, 2),
                                     jnp.flip(ig[1], 2), jnp.flip(fg[1], 2)), 2)
    hs = head_rms((h_fwd + h_bwd).transpose(0, 2, 1, 3)).reshape(b, s, ML_WIDTH)
    out = hs * norm_w.astype(jnp.float32) * jax.nn.sigmoid(o_pre.astype(jnp.float32))
    return out.astype(q.dtype)


def centred_depthwise_conv(x, w):
    c = x.shape[-1]
    return lax.conv_general_dilated(
        x, w[:, None, :].astype(x.dtype), window_strides=(1,),
        padding=[(CONV_K // 2, CONV_K // 2)],
        dimension_numbers=('NWC', 'WIO', 'NWC'), feature_group_count=c)


def gdn_direction(q, k, v, g, beta):
    b, h, s, dk = q.shape
    dv = v.shape[-1]
    L = GDN_CHUNK
    nc = s // L
    q = (q * dk ** -0.5).reshape(b, h, nc, L, dk)
    k = k.reshape(b, h, nc, L, dk)
    v = v.reshape(b, h, nc, L, dv)
    beta = beta.reshape(b, h, nc, L)
    gc = jnp.cumsum(g.reshape(b, h, nc, L), axis=-1)
    incl = jnp.tril(jnp.ones((L, L), dtype=bool))
    strict = jnp.tril(jnp.ones((L, L), dtype=bool), -1)
    diff = gc[..., :, None] - gc[..., None, :]
    lmask = jnp.where(incl, jnp.exp(jnp.where(incl, diff, 0.0)), 0.0)
    kb = k * beta[..., None]
    a = jnp.where(strict, jnp.einsum('bhnld,bhnsd->bhnls', kb, k) * lmask, 0.0)
    eye = jnp.eye(L, dtype=jnp.float32)
    t = lax.linalg.triangular_solve(a + eye, jnp.broadcast_to(eye, a.shape),
                                    left_side=True, lower=True, unit_diagonal=True)
    u = jnp.einsum('bhnls,bhnse->bhnle', t, v * beta[..., None])
    wk = jnp.einsum('bhnls,bhnsd->bhnld', t, kb * jnp.exp(gc)[..., None])
    attn = jnp.where(incl, jnp.einsum('bhnld,bhnsd->bhnls', q, k) * lmask, 0.0)
    q_dec = q * jnp.exp(gc)[..., None]
    g_last = gc[..., -1]
    k_state = k * jnp.exp(g_last[..., None] - gc)[..., None]

    def step(state, xs):
        u_c, w_c, a_c, qd_c, ks_c, gl_c = xs
        v_new = u_c - jnp.einsum('bhld,bhde->bhle', w_c, state)
        o = jnp.einsum('bhld,bhde->bhle', qd_c, state) + jnp.einsum('bhls,bhse->bhle', a_c, v_new)
        state = state * jnp.exp(gl_c)[..., None, None] + jnp.einsum('bhld,bhle->bhde', ks_c, v_new)
        return state, o

    xs = tuple(jnp.moveaxis(t_, 2, 0) for t_ in (u, wk, attn, q_dec, k_state, g_last))
    _, o = lax.scan(step, jnp.zeros((b, h, dk, dv), jnp.float32), xs)
    return jnp.moveaxis(o, 0, 2).reshape(b, h, s, dv)


def gated_deltanet_mixer(q, k, v, z, beta_pre, alpha_pre, conv_w, a_log, dt_bias, norm_w):
    b, s, _ = q.shape
    qkv = jax.nn.silu(centred_depthwise_conv(jnp.concatenate([q, k, v], axis=-1), conv_w))
    qc, kc, vc = jnp.split(qkv, 3, axis=-1)

    def heads(t):
        return t.reshape(b, s, GDN_HEADS, HEAD_DIM).transpose(0, 2, 1, 3).astype(jnp.float32)

    qh, kh, vh = l2norm(heads(qc)), l2norm(heads(kc)), heads(vc)
    beta = jax.nn.sigmoid(beta_pre.reshape(b, s, N_DIR, GDN_HEADS).astype(jnp.float32)).transpose(2, 0, 3, 1)
    g = (-jnp.exp(a_log.astype(jnp.float32)) * jax.nn.softplus(
        alpha_pre.reshape(b, s, N_DIR, GDN_HEADS).astype(jnp.float32) + dt_bias.astype(jnp.float32))).transpose(2, 0, 3, 1)
    o_fwd = gdn_direction(qh, kh, vh, g[0], beta[0])
    o_bwd = jnp.flip(gdn_direction(jnp.flip(qh, 2), jnp.flip(kh, 2), jnp.flip(vh, 2),
                                   jnp.flip(g[1], 2), jnp.flip(beta[1], 2)), 2)
    o = head_rms((o_fwd + o_bwd).transpose(0, 2, 1, 3)).reshape(b, s, GDN_WIDTH)
    o = o * norm_w.astype(jnp.float32) * jax.nn.silu(z.astype(jnp.float32))
    return o.astype(z.dtype)


def memory_cross_attention(h, mem_n, w_q, w_kv, w_o):
    b, s, _ = h.shape
    m = mem_n.shape[1]
    q = (h @ w_q).reshape(b, s, XA_HEADS, XA_HEAD_DIM)
    kk, vv = jnp.split(mem_n @ w_kv, 2, axis=-1)
    kk = kk.reshape(b, m, XA_HEADS, XA_HEAD_DIM)
    vv = vv.reshape(b, m, XA_HEADS, XA_HEAD_DIM)
    logits = jnp.einsum('bshd,bmhd->bhsm', q, kk).astype(jnp.float32) * XA_HEAD_DIM ** -0.5
    p = jax.nn.softmax(logits, axis=-1)
    o = jnp.einsum('bhsm,bmhd->bshd', p.astype(vv.dtype), vv).reshape(b, s, XA_HEADS * XA_HEAD_DIM)
    return o @ w_o


def setup_inputs(seed: int = 0) -> dict:
    key = jax.random.key(seed)
    ks = jax.random.split(key, 24)
    f32 = jnp.float32

    def nrm(k, shape, scale):
        return jax.random.normal(k, shape, f32) * scale

    def gain(k, shape):
        return 1.0 + 0.02 * jax.random.normal(k, shape, f32)

    dt = jnp.exp(jax.random.uniform(ks[12], (DEPTH, N_DIR, GDN_HEADS), f32, math.log(1e-3), math.log(1e-1)))
    return {
        'x': nrm(ks[0], (BATCH, SEQ, D_MODEL), 1.0),
        'mem': nrm(ks[1], (BATCH, N_MEM, D_MODEL), 1.0),
        'norm_mix_w': gain(ks[2], (DEPTH, D_MODEL)),
        'w_in': nrm(ks[3], (DEPTH, D_MODEL, P_IN), D_MODEL ** -0.5),
        'na_rel_bias': nrm(ks[4], (DEPTH, NA_HEADS, 2 * NA_WIN_ROWS - 1, 2 * NA_WIN_COLS - 1), 0.02),
        'ml_i_bias': nrm(ks[5], (DEPTH, N_DIR, ML_HEADS), 0.1),
        'ml_f_bias': 3.0 + 3.0 * jax.random.uniform(ks[6], (DEPTH, N_DIR, ML_HEADS), f32),
        'ml_norm_w': gain(ks[7], (DEPTH, ML_WIDTH)),
        'gdn_conv_w': nrm(ks[8], (DEPTH, CONV_K, 3 * GDN_WIDTH), CONV_K ** -0.5),
        'gdn_a_log': jnp.log(jax.random.uniform(ks[9], (DEPTH, N_DIR, GDN_HEADS), f32, 1.0, 16.0)),
        'gdn_dt_bias': dt + jnp.log(-jnp.expm1(-dt)),
        'gdn_norm_w': gain(ks[10], (DEPTH, GDN_WIDTH)),
        'w_out': nrm(ks[11], (DEPTH, D_MIX, D_MODEL), D_MIX ** -0.5),
        'norm_xa_w': gain(ks[13], (DEPTH, D_MODEL)),
        'norm_mem_w': gain(ks[14], (DEPTH, D_MODEL)),
        'w_xq': nrm(ks[15], (DEPTH, D_MODEL, XA_HEADS * XA_HEAD_DIM), D_MODEL ** -0.5),
        'w_xkv': nrm(ks[16], (DEPTH, D_MODEL, 2 * XA_HEADS * XA_HEAD_DIM), D_MODEL ** -0.5),
        'w_xo': nrm(ks[17], (DEPTH, XA_HEADS * XA_HEAD_DIM, D_MODEL), (XA_HEADS * XA_HEAD_DIM) ** -0.5),
        'norm_ffn_w': gain(ks[18], (DEPTH, D_MODEL)),
        'w_ff1': nrm(ks[19], (DEPTH, D_MODEL, D_FF), D_MODEL ** -0.5),
        'w_ff2': nrm(ks[20], (DEPTH, D_FF, D_MODEL), D_FF ** -0.5),
        'norm_out_w': gain(ks[21], (D_MODEL,)),
    }


def reference(x, mem, norm_mix_w, w_in, na_rel_bias, ml_i_bias, ml_f_bias, ml_norm_w,
              gdn_conv_w, gdn_a_log, gdn_dt_bias, gdn_norm_w, w_out, norm_xa_w, norm_mem_w,
              w_xq, w_xkv, w_xo, norm_ffn_w, w_ff1, w_ff2, norm_out_w):
    b, s, _ = x.shape
    for l in range(DEPTH):
        h = rmsnorm(x, norm_mix_w[l])
        (na_q, na_k, na_v, ml_q, ml_k, ml_v, ml_o, ml_i, ml_f,
         gd_q, gd_k, gd_v, gd_z, gd_b, gd_a) = jnp.split(h @ w_in[l], IN_OFFSETS, axis=-1)
        y_na = neighbourhood_attention(na_q.reshape(b, s, NA_HEADS, HEAD_DIM),
                                       na_k.reshape(b, s, NA_HEADS, HEAD_DIM),
                                       na_v.reshape(b, s, NA_HEADS, HEAD_DIM), na_rel_bias[l])
        y_ml = mlstm_mixer(ml_q, ml_k, ml_v, ml_o, ml_i, ml_f, ml_i_bias[l], ml_f_bias[l], ml_norm_w[l])
        y_gd = gated_deltanet_mixer(gd_q, gd_k, gd_v, gd_z, gd_b, gd_a, gdn_conv_w[l],
                                    gdn_a_log[l], gdn_dt_bias[l], gdn_norm_w[l])
        x = x + jnp.concatenate([y_na, y_ml, y_gd], axis=-1) @ w_out[l]
        x = x + memory_cross_attention(rmsnorm(x, norm_xa_w[l]), rmsnorm(mem, norm_mem_w[l]),
                                       w_xq[l], w_xkv[l], w_xo[l])
        h = rmsnorm(x, norm_ffn_w[l])
        x = x + jnp.square(jax.nn.relu(h @ w_ff1[l])) @ w_ff2[l]
    return rmsnorm(x, norm_out_w)
```

```cpp
#ifndef EMU
#include <hip/hip_runtime.h>
#include <cstdio>
#include <cstdint>
#define DEV __device__ __forceinline__
#define LAS __attribute__((address_space(3)))
#define GAS __attribute__((address_space(1)))
#else
#include "emu.h"
#define DEV inline
#define LAS
#define GAS
#endif

#ifndef CFG_BATCH
#define CFG_BATCH 8
#endif
#ifndef CFG_SEQ
#define CFG_SEQ 8192
#endif
constexpr int BATCH = CFG_BATCH, SEQ = CFG_SEQ, D = 1024, DEPTH = 2, NMEM = 256, FF = 4096;
constexpr int T = BATCH * SEQ;
constexpr int NC = SEQ / 64;
constexpr int GROWS = SEQ / 64;
constexpr int NMEMROWS = BATCH * NMEM;
constexpr int NPROJ = 3840;
constexpr int NAB_LD = 1152, MLB_LD = 1024, GDB_LD = 1536, GATES_LD = 64;
constexpr int NITEM_ML = BATCH * 4 * 2 * NC;
constexpr int NITEM_GD = BATCH * 6 * 2 * NC;
constexpr float EPS = 1e-6f;
constexpr int NWAVES = 8;

typedef unsigned short bf16;
typedef unsigned int u32;
typedef unsigned long long u64;
typedef short bf16x8 __attribute__((ext_vector_type(8)));
typedef float f32x4 __attribute__((ext_vector_type(4)));
typedef unsigned u32x4 __attribute__((ext_vector_type(4)));
typedef unsigned u32x2 __attribute__((ext_vector_type(2)));

constexpr size_t MiB = 1u << 20;
constexpr size_t al256(size_t x) { return (x + 255) & ~(size_t)255; }
constexpr size_t WS_CTL = 0, CTL_ZERO_BYTES = 1 * MiB;
constexpr size_t WS_WIN = 1 * MiB;
constexpr size_t WS_WOUT = WS_WIN + (size_t)DEPTH * NPROJ * D * 2;
constexpr size_t WS_WXQ = WS_WOUT + (size_t)DEPTH * D * D * 2;
constexpr size_t WS_WXO = WS_WXQ + (size_t)DEPTH * D * D * 2;
constexpr size_t WS_W1 = WS_WXO + (size_t)DEPTH * D * D * 2;
constexpr size_t WS_W2 = WS_W1 + (size_t)DEPTH * FF * D * 2;
constexpr size_t WS_KX = WS_W2 + (size_t)DEPTH * FF * D * 2;
constexpr size_t WS_VTX = WS_KX + (size_t)DEPTH * NMEMROWS * D * 2;
constexpr size_t WS_XY = al256(WS_VTX + (size_t)DEPTH * NMEMROWS * D * 2);
constexpr size_t WS_NAB = WS_XY + (size_t)T * D * 2;
constexpr size_t WS_MLB = WS_NAB + (size_t)T * NAB_LD * 2;
constexpr size_t WS_GDB = WS_MLB + (size_t)T * MLB_LD * 2;
constexpr size_t WS_GATES = WS_GDB + (size_t)T * GDB_LD * 2;
constexpr size_t WS_FREE = WS_GATES + (size_t)T * GATES_LD * 4;
constexpr size_t WS_KN = WS_FREE;
constexpr size_t WS_KNT = WS_KN + (size_t)T * 384 * 2;
constexpr size_t WS_VNT = WS_KNT + (size_t)T * 384 * 2;
constexpr size_t WS_WF = WS_VNT + (size_t)T * 384 * 2;
constexpr size_t WS_ATT = WS_WF + (size_t)NITEM_GD * 8192;
constexpr size_t WS_RSS = WS_ATT + (size_t)NITEM_GD * 8192;
constexpr size_t WS_END0 = WS_RSS + (size_t)T * 64;
constexpr size_t WS_CML = WS_NAB;
constexpr size_t WS_NML = WS_CML + (size_t)NITEM_ML * 8192;
constexpr size_t WS_SML = WS_NML + (size_t)NITEM_ML * 256;
constexpr size_t WS_GST = WS_SML + (size_t)NITEM_ML * 16;
static_assert(WS_GST + (size_t)NITEM_GD * 768 <= WS_MLB, "NAB overlays");
constexpr size_t PRO_BYTES = (size_t)DEPTH * 2048 * D * 2 + (size_t)DEPTH * NMEMROWS * D * 2;
constexpr bool PRO_IN_OUT = (size_t)T * D * 2 >= PRO_BYTES;
constexpr size_t PRO_WXKV = PRO_IN_OUT ? (size_t)T * D * 2 : WS_END0;
constexpr size_t PRO_MEMN = PRO_WXKV + (size_t)DEPTH * 2048 * D * 2;
constexpr size_t WS_END1 = PRO_IN_OUT ? WS_END0 : WS_END0 + PRO_BYTES;
constexpr size_t ABS_BYTES = (size_t)2 * DEPTH * BATCH * D * D * 2;
constexpr bool ABS_IN_OUT = PRO_IN_OUT && (size_t)T * D * 2 >= PRO_BYTES + ABS_BYTES;
constexpr size_t ABS_MT = ABS_IN_OUT ? PRO_MEMN + (size_t)DEPTH * NMEMROWS * D * 2 : WS_END1;
constexpr size_t ABS_NT = ABS_MT + ABS_BYTES / 2;
constexpr size_t WS_END = ABS_IN_OUT ? WS_END1 : WS_END1 + ABS_BYTES;
constexpr size_t WS_XB2 = WS_NAB;
constexpr size_t WS_H = WS_NAB + (size_t)T * D * 2;
static_assert(WS_H + (size_t)T * FF * 2 <= WS_RSS, "H overlay");
constexpr size_t WS_QX = WS_MLB;
static_assert(CFG_BATCH != 8 || CFG_SEQ != 8192 || WS_END <= 1024 * MiB, "workspace budget");
constexpr int CW_BAR = 4096;

constexpr int RING_BYTES = 131072;
constexpr int WSCR_BYTES = 16640;
constexpr int WSM_OFF = 8 * WSCR_BYTES;
constexpr int MISC_OFF = WSM_OFF + 8 * 1024;
constexpr int RSSL_OFF = MISC_OFF + 1024;
constexpr int STG_OFF = 147456;
constexpr int LDS_BYTES = 163840;
static_assert(MISC_OFF + 256 <= RSSL_OFF && RSSL_OFF + 4096 <= STG_OFF && STG_OFF + 8 * 2048 <= LDS_BYTES, "LDS map");

DEV u32 f2bf(float f) { u32 u = __builtin_bit_cast(u32, f); return (u + 0x7fffu + ((u >> 16) & 1u)) >> 16; }
#ifndef EMU
typedef float f32x2_t __attribute__((ext_vector_type(2)));
typedef __bf16 bf16x2_t __attribute__((ext_vector_type(2)));
DEV u32 pk2(float lo, float hi) { f32x2_t v = {lo, hi}; bf16x2_t b = __builtin_convertvector(v, bf16x2_t); return __builtin_bit_cast(u32, b); }
#else
DEV u32 pk2(float lo, float hi) { return f2bf(lo) | (f2bf(hi) << 16); }
#endif
DEV float bflo(u32 w) { return __builtin_bit_cast(float, w << 16); }
DEV float bfhi(u32 w) { return __builtin_bit_cast(float, w & 0xffff0000u); }
DEV float bf2f(bf16 b) { return __builtin_bit_cast(float, (u32)b << 16); }
DEV bf16x8 pack8(f32x4 a, f32x4 b) { u32x4 w; w.x = pk2(a[0], a[1]); w.y = pk2(a[2], a[3]); w.z = pk2(b[0], b[1]); w.w = pk2(b[2], b[3]); return __builtin_bit_cast(bf16x8, w); }
DEV bf16x8 frag2(u32x2 lo, u32x2 hi) { u32x4 w; w.x = lo.x; w.y = lo.y; w.z = hi.x; w.w = hi.y; return __builtin_bit_cast(bf16x8, w); }
DEV u32 rot16(u32 x) { return (x >> 16) | (x << 16); }
DEV u32x2 rev4(u32x2 v) { u32x2 r; r.x = rot16(v.y); r.y = rot16(v.x); return r; }
DEV u32x4 rev8(u32x4 v) { u32x4 r; r.x = rot16(v.w); r.y = rot16(v.z); r.z = rot16(v.y); r.w = rot16(v.x); return r; }
DEV u32x4 ld16(const void* p) { return *(const u32x4*)p; }
DEV u32x2 ld8(const void* p) { return *(const u32x2*)p; }
DEV bf16x8 ldfrag(const void* p) { return __builtin_bit_cast(bf16x8, *(const u32x4*)p); }
#ifndef EMU
DEV float fexp(float x) { return __expf(x); }
DEV float fexp2(float x) { return __builtin_amdgcn_exp2f(x); }
DEV float frcp(float x) { return __builtin_amdgcn_rcpf(x); }
DEV float frsq(float x) { return __builtin_amdgcn_rsqf(x); }
#else
DEV float fexp(float x) { return expf(x); }
DEV float fexp2(float x) { return exp2f(x); }
DEV float frcp(float x) { return 1.f / x; }
DEV float frsq(float x) { return 1.f / sqrtf(x); }
#endif
DEV float sigmoidf_(float x) { return frcp(1.f + fexp(-x)); }
DEV float logsigmoidf_(float x) { return fminf(x, 0.f) - log1pf(expf(-fabsf(x))); }
DEV float softplusf_(float x) { return fmaxf(x, 0.f) + log1pf(expf(-fabsf(x))); }
#ifndef EMU
DEV f32x4 mfma16(bf16x8 a, bf16x8 b, f32x4 c) { return __builtin_amdgcn_mfma_f32_16x16x32_bf16(a, b, c, 0, 0, 0); }
DEV float shfl_xor_f(float v, int m) { return __shfl_xor(v, m); }
DEV float shfl_f(float v, int src) { return __shfl(v, src); }
DEV float shfl_up_f(float v, int d) { return __shfl_up(v, d); }
DEV float lane63_f(float v) { return __builtin_bit_cast(float, __builtin_amdgcn_readlane(__builtin_bit_cast(int, v), 63)); }
DEV void wave_sync() { __builtin_amdgcn_fence(__ATOMIC_RELEASE, "wavefront"); __builtin_amdgcn_wave_barrier(); __builtin_amdgcn_fence(__ATOMIC_ACQUIRE, "wavefront"); }
DEV int rfl(int v) { return __builtin_amdgcn_readfirstlane(v); }
#define NT_STORE16(p, v) __builtin_nontemporal_store((v), (u32x4*)(p))
#define LAUNDER_V(x) asm volatile("" : "+v"(x))
#define SCHED_FENCE() __builtin_amdgcn_sched_barrier(0)
DEV void lds_barrier() { asm volatile("s_waitcnt lgkmcnt(0)" ::: "memory"); __builtin_amdgcn_s_barrier(); asm volatile("" ::: "memory"); }
DEV int lane_id() { int r; asm volatile("v_mbcnt_lo_u32_b32 %0, -1, 0\n\tv_mbcnt_hi_u32_b32 %0, -1, %0" : "=v"(r)); return r; }
#else
DEV f32x4 mfma16(bf16x8 a, bf16x8 b, f32x4 c) { return emu_mfma16(a, b, c); }
DEV float shfl_xor_f(float v, int m) { return emu_shfl(v, emu_lane() ^ m); }
DEV float shfl_f(float v, int src) { return emu_shfl(v, src); }
DEV float shfl_up_f(float v, int d) { int l = emu_lane(); return emu_shfl(v, l >= d ? l - d : l); }
DEV float lane63_f(float v) { return emu_shfl(v, 63); }
DEV void wave_sync() { emu_wave_sync(); }
DEV int rfl(int v) { return v; }
#define NT_STORE16(p, v) (*(u32x4*)(p) = (v))
#define LAUNDER_V(x) do {} while (0)
#define SCHED_FENCE() do {} while (0)
DEV void lds_barrier() { __syncthreads(); }
DEV int lane_id() { return emu_lane(); }
#endif
typedef short v4i16_t __attribute__((ext_vector_type(4)));
#ifndef EMU
DEV u32x2 lds_tr4(const LAS void* p) { return __builtin_bit_cast(u32x2, __builtin_amdgcn_ds_read_tr16_b64_v4i16((LAS v4i16_t*)p)); }
#else
DEV u32x2 lds_tr4(const void* p) { return emu_tr16(p); }
#endif
DEV float wave_max(float v) {
#pragma unroll
    for (int o = 1; o < 64; o <<= 1) v = fmaxf(v, shfl_xor_f(v, o));
    return v; }
DEV float wave_sum(float v) {
#pragma unroll
    for (int o = 1; o < 64; o <<= 1) v += shfl_xor_f(v, o);
    return v; }
DEV float wave_incl_scan(float v, int lane) {
#pragma unroll
    for (int d = 1; d < 64; d <<= 1) { const float t = shfl_up_f(v, d); if (lane >= d) v += t; }
    return v; }

namespace pg8 {
#define PG8_LAS LAS
typedef unsigned short bf16_t;


constexpr int BM = 256, BK = 64, HALF = 128, HTB = HALF * BK * 2  , STAGE_BYTES = 8 * HTB, NXCD = 8, WGM = 8;

__host__ __device__ __forceinline__ int lds_byte(int r, int c) { const int st = (r >> 4) * 2 + (c >> 5), rr = r & 15, cc = c & 31, ob = rr * 64 + cc * 2; return st * 1024 + (ob ^ (((ob >> 9) & 1) << 5)); }
__host__ __device__ __forceinline__ void stage_rc(int b, int& R, int& C) { const int st = b / 1024, sb = b % 1024, swz = sb ^ (((sb >> 9) & 1) << 5); R = (st >> 1) * 16 + swz / 64; C = (st & 1) * 32 + (swz % 64) / 2; }
__host__ __device__ __forceinline__ int perm32(int rho) { const int n = rho >> 4, i = rho & 15; return 8 * (i >> 2) + 4 * n + (i & 3); }

struct Unit { int pm, pn, bt; };
struct Gemm { const bf16_t* A; const bf16_t* Bt; int M, N, K; };

struct StaticOrder {
    int nM, nN, nwg, G, c, wv;
    int bmode, bdiv;
    __host__ __device__ void init(int M, int N, int G_, int c_) { nM = M / BM; nN = N / BM; nwg = nM * nN; G = G_; c = c_; bmode = 0; bdiv = 1; }
    __host__ __device__ bool next(int i, Unit& u) const {
        const long L = (long)i * G + c; if (L >= nwg) return false;
        int wgid = (int)L; { const int q = nwg / NXCD, r = nwg % NXCD, xcd = wgid % NXCD, off = wgid / NXCD; wgid = (xcd < r ? xcd * (q + 1) : r * (q + 1) + (xcd - r) * q) + off; }
        const int nig = WGM * nN, gid = wgid / nig, fm = gid * WGM, gsz = (nM - fm) < WGM ? (nM - fm) : WGM;
        u.pm = fm + ((wgid % nig) % gsz); u.pn = (wgid % nig) / gsz;
        u.bt = bmode == 0 ? u.pn : (bmode == 1 ? (u.pm / bdiv) * nN + u.pn : (bmode == 2 ? (u.pm & 3) * nN + u.pn : u.pn * 4 + (u.pm >> 2))); return true;
    }
    __device__ __forceinline__ void a_ready(const Unit&) const {}
    __device__ __forceinline__ void done(const Unit&) const {}
};
DEV void row_rstd8_lds(const LAS float* rssl, int rl0, float scale, float (&rs)[8]) {
#pragma unroll
    for (int g = 0; g < 8; ++g) { const f32x4 a = *(const LAS f32x4*)(rssl + (rl0 + (g >> 2) * HALF + (g & 3) * 16) * 4); const float s = (a[0] + a[1]) + (a[2] + a[3]); rs[g] = scale / sqrtf(s * (1.f / 1024.f) + 1e-6f); }
}
DEV void row_rstd8(const float* rss, int row0, int fq, float scale, float (&rs)[8]) {
    f32x4 a[8];
#pragma unroll
    for (int g = 0; g < 8; ++g) a[g] = *(const f32x4*)(rss + (size_t)(row0 + (g >> 2) * HALF + (g & 3) * 16) * 4);
    SCHED_FENCE();
#pragma unroll
    for (int g = 0; g < 8; ++g) { const float s = (a[g][0] + a[g][1]) + (a[g][2] + a[g][3]); rs[g] = scale / sqrtf(s * (1.f / 1024.f) + 1e-6f); }
}
DEV int stg_off(int r, int p) { return r * 128 + ((p ^ (r & 7)) << 4); }
template <bool NT> DEV void stg_store(LAS unsigned char* stg, int lane, u32x4 w0, u32x4 w1, bf16_t* tile, size_t ldc) {
    const int fr = lane & 15, fq = lane >> 4;
    *(LAS u32x4*)(stg + stg_off(fr, fq)) = w0; *(LAS u32x4*)(stg + stg_off(fr, 4 + fq)) = w1;
    wave_sync();
#pragma unroll
    for (int s_ = 0; s_ < 2; ++s_) { const int r = 8 * s_ + (lane >> 3), p = lane & 7; const u32x4 v = *(const LAS u32x4*)(stg + stg_off(r, p));
        if (NT) NT_STORE16(tile + (size_t)r * ldc + 8 * p, v); else *(u32x4*)(tile + (size_t)r * ldc + 8 * p) = v; }
    wave_sync();
}
DEV u32x4 pack8u(const f32x4 a, const f32x4 b) { u32x4 w; w.x = pk2(a[0], a[1]); w.y = pk2(a[2], a[3]); w.z = pk2(b[0], b[1]); w.w = pk2(b[2], b[3]); return w; }
struct EpiInProj {
    static constexpr bool PERM = true, AFTER_DRAIN = false, RSS_LDS = true;
    bf16_t* nab; bf16_t* mlb; bf16_t* gdb; float* gates; const float* rss; LAS unsigned char* stg0;
    DEV void operator()(const f32x4 (&acc)[2][2][4][2], const Unit& u, int wr, int wc, int fr, int fq) const {
        const int row0 = u.pm * BM + wr * 64 + fr; const int pn = u.pn, lane = fr + 16 * fq; LAS unsigned char* stg = stg0 + (wr * 4 + wc) * 2048;
        const int i5 = pn >= 5, i9 = pn >= 9;
        bf16_t* base = nab + (size_t)i5 * ((WS_MLB - WS_NAB) / 2) + (size_t)i9 * ((WS_GDB - WS_MLB) / 2);
        const int ldc = NAB_LD + i5 * (MLB_LD - NAB_LD) + i9 * (GDB_LD - MLB_LD), colt = (pn - 5 * i5 - 4 * i9) * 256;
        float rsv[8];
        row_rstd8_lds((const LAS float*)(stg0 + (RSSL_OFF - STG_OFF)), wr * 64 + fr, 1.f, rsv);
        if (pn == 4 && wc >= 2) {
            if (wc == 2) {
#pragma unroll
                for (int g = 0; g < 8; ++g) { const int ai = g >> 2, m = g & 3; float* gp = gates + (size_t)(row0 + ai * HALF + m * 16) * GATES_LD + 8 * fq;
#pragma unroll
                    for (int bj = 0; bj < 2; ++bj) { *(f32x4*)(gp + 32 * bj) = acc[ai][bj][m][0] * rsv[g]; *(f32x4*)(gp + 32 * bj + 4) = acc[ai][bj][m][1] * rsv[g]; } } }
            return; }
#pragma unroll
        for (int g = 0; g < 8; ++g) { const int ai = g >> 2, m = g & 3; const float rs = rsv[g];
            stg_store<false>(stg, lane, pack8u(acc[ai][0][m][0] * rs, acc[ai][0][m][1] * rs), pack8u(acc[ai][1][m][0] * rs, acc[ai][1][m][1] * rs),
                             base + (size_t)(u.pm * BM + wr * 64 + ai * HALF + m * 16) * ldc + colt + wc * 64, (size_t)ldc); }
    }
};
struct EpiResid {
    static constexpr bool PERM = true, AFTER_DRAIN = false, RSS_LDS = false;
    bf16_t* x; int ldc; float* rss; LAS unsigned char* stg0; LAS float* xch;
    DEV void operator()(const f32x4 (&acc)[2][2][4][2], const Unit& u, int wr, int wc, int fr, int fq) const {
        const int lane = fr + 16 * fq; LAS unsigned char* stg = stg0 + (wr * 4 + wc) * 2048;
        bf16_t* tile0 = x + (size_t)(u.pm * BM + wr * 64) * ldc + u.pn * BM + wc * 64;
        u32x4 rr[8][2];
#pragma unroll
        for (int g = 0; g < 8; ++g)
#pragma unroll
            for (int s_ = 0; s_ < 2; ++s_) rr[g][s_] = *(const u32x4*)(tile0 + (size_t)((g >> 2) * HALF + (g & 3) * 16 + 8 * s_ + (lane >> 3)) * ldc + 8 * (lane & 7));
#pragma unroll
        for (int g = 0; g < 8; ++g) { const int ai = g >> 2, m = g & 3; const size_t row = (size_t)(u.pm * BM + wr * 64 + ai * HALF + m * 16 + fr); float ss = 0.f;
#pragma unroll
            for (int s_ = 0; s_ < 2; ++s_) *(LAS u32x4*)(stg + stg_off(8 * s_ + (lane >> 3), lane & 7)) = rr[g][s_];
            wave_sync();
            u32x4 w[2];
#pragma unroll
            for (int bj = 0; bj < 2; ++bj) { const u32x4 r = *(const LAS u32x4*)(stg + stg_off(fr, 4 * bj + fq));
                const f32x4 v0 = (f32x4){bflo(r.x), bfhi(r.x), bflo(r.y), bfhi(r.y)} + acc[ai][bj][m][0], v1 = (f32x4){bflo(r.z), bfhi(r.z), bflo(r.w), bfhi(r.w)} + acc[ai][bj][m][1];
                w[bj] = pack8u(v0, v1);
                const float q0 = bflo(w[bj].x), q1 = bfhi(w[bj].x), q2 = bflo(w[bj].y), q3 = bfhi(w[bj].y), q4 = bflo(w[bj].z), q5 = bfhi(w[bj].z), q6 = bflo(w[bj].w), q7 = bfhi(w[bj].w);
                ss += ((q0 * q0 + q1 * q1) + (q2 * q2 + q3 * q3)) + ((q4 * q4 + q5 * q5) + (q6 * q6 + q7 * q7)); }
            wave_sync();
            stg_store<false>(stg, lane, w[0], w[1], tile0 + (size_t)(ai * HALF + m * 16) * ldc, (size_t)ldc);
            ss += shfl_xor_f(ss, 16); ss += shfl_xor_f(ss, 32);
            if (fq == 0) xch[(wr * 64 + ai * HALF + m * 16 + fr) * 4 + wc] = ss; }
        lds_barrier();
        if (wc == 0) {
#pragma unroll
            for (int ai = 0; ai < 2; ++ai) { const int rl = wr * 64 + ai * HALF + lane; const f32x4 a = *(const LAS f32x4*)(xch + rl * 4);
                rss[(size_t)(u.pm * BM + rl) * 4 + u.pn] = (a[0] + a[1]) + (a[2] + a[3]); } }
    }
};
template <int ACT, int MODE = 0> struct EpiBf16 {
    static constexpr bool PERM = true, AFTER_DRAIN = false, RSS_LDS = (ACT == 1);
    bf16_t* O; int ldc; const float* rss; bf16_t* O2; LAS unsigned char* stg0;
    DEV void operator()(const f32x4 (&acc)[2][2][4][2], const Unit& u, int wr, int wc, int fr, int fq) const {
        int rowb = u.pm * BM, colb = u.pn * BM; bf16_t* O = this->O; const int lane = fr + 16 * fq; LAS unsigned char* stg = stg0 + (wr * 4 + wc) * 2048;
        if (MODE == 1) { rowb = (u.pm & 3) * BM; colb = (u.pm >> 2) * BM; O += (size_t)u.pn * D * D; }
        if (MODE == 2) { rowb = 0; colb = 0; O = ((u.pn >> 2) ? O2 : O) + (size_t)(u.pm * 4 + (u.pn & 3)) * (BM * BM); }
        float rsv[8];
        if (ACT == 1) row_rstd8_lds((const LAS float*)(stg0 + (RSSL_OFF - STG_OFF)), wr * 64 + fr, 1.f, rsv);
        else {
#pragma unroll
            for (int g = 0; g < 8; ++g) rsv[g] = 1.f; }
#pragma unroll
        for (int g = 0; g < 8; ++g) { const int ai = g >> 2, m = g & 3; const float rs = rsv[g]; u32x4 w[2];
#pragma unroll
            for (int bj = 0; bj < 2; ++bj) { f32x4 v0 = acc[ai][bj][m][0] * rs, v1 = acc[ai][bj][m][1] * rs;
                if (ACT == 1) {
#pragma unroll
                    for (int j = 0; j < 4; ++j) { const float a = fmaxf(v0[j], 0.f), b = fmaxf(v1[j], 0.f); v0[j] = a * a; v1[j] = b * b; } }
                w[bj] = pack8u(v0, v1); }
            stg_store<ACT == 1>(stg, lane, w[0], w[1], O + (size_t)(rowb + wr * 64 + ai * HALF + m * 16) * ldc + colb + wc * 64, (size_t)ldc); }
    }
};
struct EpiSoftmax {
    static constexpr bool PERM = true, AFTER_DRAIN = false, RSS_LDS = true;
    bf16_t* P; const float* rss; LAS float* xch; LAS unsigned char* stg0;
    DEV void operator()(f32x4 (&acc)[2][2][4][2], const Unit& u, int wr, int wc, int fr, int fq) const {
        const int rl0 = wr * 64 + fr, lane = fr + 16 * fq; LAS unsigned char* stg = stg0 + (wr * 4 + wc) * 2048;
        float mw[8];
        row_rstd8_lds((const LAS float*)(stg0 + (RSSL_OFF - STG_OFF)), rl0, 1.44269504088896f, mw);
#pragma unroll
        for (int g = 0; g < 8; ++g) { const int ai = g >> 2, m = g & 3, rl = rl0 + ai * HALF + m * 16;
            const float rs = mw[g]; float mx = -3.0e38f;
#pragma unroll
            for (int bj = 0; bj < 2; ++bj)
#pragma unroll
                for (int n = 0; n < 2; ++n) { const f32x4 v = acc[ai][bj][m][n] * rs; acc[ai][bj][m][n] = v; mx = fmaxf(fmaxf(mx, fmaxf(v[0], v[1])), fmaxf(v[2], v[3])); }
            mx = fmaxf(mx, shfl_xor_f(mx, 16)); mx = fmaxf(mx, shfl_xor_f(mx, 32)); float sm = 0.f;
#pragma unroll
            for (int bj = 0; bj < 2; ++bj)
#pragma unroll
                for (int n = 0; n < 2; ++n) { f32x4 v = acc[ai][bj][m][n];
#pragma unroll
                    for (int j = 0; j < 4; ++j) v[j] = fexp2(v[j] - mx);
                    acc[ai][bj][m][n] = v; sm += (v[0] + v[1]) + (v[2] + v[3]); }
            sm += shfl_xor_f(sm, 16); sm += shfl_xor_f(sm, 32); mw[g] = mx;
            if (fq == 0) { LAS float* xp = xch + (rl * 4 + wc) * 2; xp[0] = mx; xp[1] = sm; } }
        lds_barrier();
#pragma unroll
        for (int g = 0; g < 8; ++g) { const int ai = g >> 2, m = g & 3, rl = rl0 + ai * HALF + m * 16;
            const f32x4 a = *(const LAS f32x4*)(xch + rl * 8), b = *(const LAS f32x4*)(xch + rl * 8 + 4);
            const float M = fmaxf(fmaxf(a[0], a[2]), fmaxf(b[0], b[2]));
            const float L = (a[1] * fexp2(a[0] - M) + a[3] * fexp2(a[2] - M)) + (b[1] * fexp2(b[0] - M) + b[3] * fexp2(b[2] - M));
            const float sc = fexp2(mw[g] - M) * frcp(L);
            stg_store<false>(stg, lane, pack8u(acc[ai][0][m][0] * sc, acc[ai][0][m][1] * sc), pack8u(acc[ai][1][m][0] * sc, acc[ai][1][m][1] * sc),
                             P + (size_t)(u.pm * BM + wr * 64 + ai * HALF + m * 16) * D + u.pn * BM + wc * 64, (size_t)D); }
    }
};
#ifdef EMU
template <class Epi, class Sched, bool ALIGN_EPI = false, bool SP2 = false>
inline void gemm_phase(unsigned char* lds, const Gemm g, const Sched& S, const Epi& E) {
    const int tid = threadIdx.x, wid = tid >> 6, lane = tid & 63, wr = wid >> 2, wc = wid & 3, fr = lane & 15, fq = lane >> 4;
    Unit u;
    for (int i = 0; S.next(i, u); ++i) {
        const float* tile = emu_gemm_tile(g.A, g.Bt, g.K, u.pm, u.bt);
        f32x4 acc[2][2][4][2];
        for (int ai = 0; ai < 2; ++ai) for (int bj = 0; bj < 2; ++bj) for (int m = 0; m < 4; ++m) for (int n = 0; n < 2; ++n) for (int j = 0; j < 4; ++j) {
            const int r = 128 * ai + 64 * wr + 16 * m + fr; const int c = Epi::PERM ? 64 * wc + 32 * bj + 8 * fq + 4 * n + j : 128 * bj + 32 * wc + 16 * n + 4 * fq + j;
            acc[ai][bj][m][n][j] = tile[r * 256 + c]; }
        if constexpr (Epi::RSS_LDS) { for (int i = tid; i < 1024; i += 512) ((float*)(lds + RSSL_OFF))[i] = E.rss[(size_t)u.pm * 1024 + i]; __syncthreads(); }
        E(acc, u, wr, wc, fr, fq);
        __syncthreads();
    }
    __syncthreads();
}
}
#endif
#ifndef EMU
template <class Epi, class Sched, bool ALIGN_EPI = false, bool SP2 = false>
__device__ __forceinline__ void gemm_phase(PG8_LAS unsigned char* lds, const Gemm g, const Sched& S, const Epi& E) {
    int tid_l = S.wv * 64 + lane_id(); asm volatile("" : "+v"(tid_l));
    const int tid = tid_l, wid = __builtin_amdgcn_readfirstlane(tid >> 6), lane = tid & 63, wr = wid >> 2, wc = wid & 3, fr = lane & 15, fq = lane >> 4;
    const int K = g.K, nt = K / BK;
    unsigned voffA[2], voffB[2];
#pragma unroll
    for (int i = 0; i < 2; ++i) { int R, C; stage_rc(tid * 16 + i * 8192, R, C); const int Rb = Epi::PERM ? (64 * (R >> 5) + perm32(R & 31)) : R;
        voffA[i] = (unsigned)(R * K + C) * 2u; voffB[i] = (unsigned)(Rb * K + C) * 2u; }
    const size_t kstep = (size_t)(BK * 2);
    const size_t hstep = (size_t)HALF * K * 2;
    const size_t hstepB = Epi::PERM ? (size_t)32 * K * 2 : hstep;
    const size_t tstep = 2 * hstep;
    const unsigned ldsw = (unsigned)wid * 1024u;
    const int aoff = lds_byte(wr * 64 + fr, fq * 8), boff = lds_byte(wc * 32 + fr, fq * 8);
#define PG8_SA(b, h) (((b) * 2 + (h)) * HTB)
#define PG8_SB(b, h) ((4 + (b) * 2 + (h)) * HTB)
#define PG8_STAGE(bufoff, gbase, voff) do { _Pragma("unroll") for (int _i = 0; _i < 2; ++_i) \
        __builtin_amdgcn_global_load_lds((const unsigned*)((const char*)(gbase) + (voff)[_i]), (PG8_LAS unsigned*)(lds + (bufoff) + ldsw + _i * 8192), 16, 0, 0); } while (0)
#define PG8_LDA(dst, b, h) do { _Pragma("unroll") for (int m = 0; m < 4; ++m) _Pragma("unroll") for (int k = 0; k < 2; ++k) dst[m][k] = *(const PG8_LAS bf16x8*)(lds + PG8_SA(b, h) + aoff + m * 2048 + k * 1024); } while (0)
#define PG8_LDB(dst, b, h) do { _Pragma("unroll") for (int n = 0; n < 2; ++n) _Pragma("unroll") for (int k = 0; k < 2; ++k) dst[n][k] = *(const PG8_LAS bf16x8*)(lds + PG8_SB(b, h) + boff + n * 2048 + k * 1024); } while (0)
#define PG8_MMA(ai, bj, At, Bt) do { __builtin_amdgcn_s_setprio(1); _Pragma("unroll") for (int m = 0; m < 4; ++m) _Pragma("unroll") for (int n = 0; n < 2; ++n) _Pragma("unroll") for (int k = 0; k < 2; ++k) \
        acc[ai][bj][m][n] = __builtin_amdgcn_mfma_f32_16x16x32_bf16(Bt[n][k], At[m][k], acc[ai][bj][m][n], 0, 0, 0); __builtin_amdgcn_s_setprio(0); } while (0)
#define PG8_WAIT_V(n) asm volatile("s_waitcnt vmcnt(" #n ")" ::: "memory")
#define PG8_WAIT_L(n) asm volatile("s_waitcnt lgkmcnt(" #n ")" ::: "memory")
#define PG8_BAR __builtin_amdgcn_s_barrier()
#define PG8_SCHED __builtin_amdgcn_sched_barrier(0)
    Unit cur, nxt; int ui = 0;
    if (!S.next(0, cur)) return;
    f32x4 acc[2][2][4][2];
#pragma unroll
    for (int a = 0; a < 2; ++a)
#pragma unroll
        for (int b = 0; b < 2; ++b)
#pragma unroll
            for (int m = 0; m < 4; ++m)
#pragma unroll
                for (int n = 0; n < 2; ++n) acc[a][b][m][n] = (f32x4){0.f, 0.f, 0.f, 0.f};
    bf16x8 At[4][2], B0[2][2], B1[2][2];
    const char* cA = (const char*)g.A + (size_t)cur.pm * tstep; const char* cB = (const char*)g.Bt + (size_t)cur.bt * tstep;
    S.a_ready(cur);
    if constexpr (SP2) {
        PG8_STAGE(PG8_SB(0, 0), cB, voffB); PG8_STAGE(PG8_SB(0, 1), cB + hstepB, voffB); PG8_STAGE(PG8_SA(0, 0), cA, voffA); PG8_STAGE(PG8_SA(0, 1), cA + hstep, voffA);
        if (wr == 1) PG8_BAR;
        PG8_WAIT_V(2); PG8_BAR;
        PG8_STAGE(PG8_SB(1, 0), cB + kstep, voffB); PG8_STAGE(PG8_SA(1, 0), cA + kstep, voffA); PG8_STAGE(PG8_SB(1, 1), cB + hstepB + kstep, voffB);
        PG8_WAIT_V(6); PG8_BAR;
    } else {
        PG8_STAGE(PG8_SB(0, 0), cB, voffB); PG8_STAGE(PG8_SA(0, 0), cA, voffA); PG8_STAGE(PG8_SB(0, 1), cB + hstepB, voffB); PG8_STAGE(PG8_SA(0, 1), cA + hstep, voffA);
        if (wr == 1) PG8_BAR;
        PG8_WAIT_V(4); PG8_BAR;
        PG8_STAGE(PG8_SB(1, 0), cB + kstep, voffB); PG8_STAGE(PG8_SA(1, 0), cA + kstep, voffA); PG8_STAGE(PG8_SB(1, 1), cB + hstepB + kstep, voffB);
        PG8_WAIT_V(6); PG8_BAR;
    }
    for (;;) {
        const bool has_next = S.next(ui + 1, nxt);
        const char* nA = has_next ? (const char*)g.A + (size_t)nxt.pm * tstep : cA; const char* nB = has_next ? (const char*)g.Bt + (size_t)nxt.bt * tstep : cB;
        for (int t = 0; t < nt; t += 2) {
            const bool last = (t == nt - 2);
            const char* a1 = cA + (size_t)(t + 1) * kstep;
            const char* a2 = last ? nA : cA + (size_t)(t + 2) * kstep; const char* b2 = last ? nB : cB + (size_t)(t + 2) * kstep;
            const char* a3 = a2 + kstep; const char* b3 = b2 + kstep;
            if (last && has_next) S.a_ready(nxt);
            if constexpr (Epi::RSS_LDS) {
                if (last && wid < 4) __builtin_amdgcn_global_load_lds((const unsigned*)((const char*)E.rss + ((size_t)cur.pm * BM + wid * 64 + lane) * 16), (PG8_LAS unsigned*)(lds + RSSL_OFF + wid * 1024), 16, 0, 0); }
            if constexpr (SP2) {
            PG8_LDB(B0, 0, 0); PG8_LDB(B1, 0, 1); PG8_SCHED; PG8_LDA(At, 0, 0); PG8_STAGE(PG8_SA(1, 1), a1 + hstep, voffA);
            PG8_WAIT_V(8); PG8_WAIT_L(0); PG8_BAR; PG8_MMA(0, 0, At, B0); PG8_MMA(0, 1, At, B1); PG8_BAR; PG8_SCHED;
            PG8_LDA(At, 0, 1); PG8_STAGE(PG8_SB(0, 0), b2, voffB); PG8_STAGE(PG8_SB(0, 1), b2 + hstepB, voffB); PG8_STAGE(PG8_SA(0, 0), a2, voffA);
            PG8_WAIT_V(8); PG8_WAIT_L(0); PG8_BAR; PG8_MMA(1, 0, At, B0); PG8_MMA(1, 1, At, B1); PG8_BAR; PG8_SCHED;
            PG8_LDB(B0, 1, 0); PG8_LDB(B1, 1, 1); PG8_SCHED; PG8_LDA(At, 1, 0); PG8_STAGE(PG8_SA(0, 1), a2 + hstep, voffA);
            PG8_WAIT_V(8); PG8_WAIT_L(0); PG8_BAR; PG8_MMA(0, 0, At, B0); PG8_MMA(0, 1, At, B1); PG8_BAR; PG8_SCHED;
            PG8_LDA(At, 1, 1); PG8_STAGE(PG8_SB(1, 0), b3, voffB); PG8_STAGE(PG8_SB(1, 1), b3 + hstepB, voffB); PG8_STAGE(PG8_SA(1, 0), a3, voffA);
            PG8_WAIT_V(8); PG8_WAIT_L(0); PG8_BAR; PG8_MMA(1, 0, At, B0); PG8_MMA(1, 1, At, B1); PG8_BAR; PG8_SCHED;
            } else {
            PG8_LDB(B0, 0, 0); PG8_SCHED; PG8_LDA(At, 0, 0); PG8_STAGE(PG8_SA(1, 1), a1 + hstep, voffA);
            PG8_WAIT_L(8); PG8_BAR; PG8_WAIT_L(0); PG8_MMA(0, 0, At, B0); PG8_BAR; PG8_SCHED;
            PG8_LDB(B1, 0, 1); PG8_STAGE(PG8_SB(0, 0), b2, voffB);
            PG8_BAR; PG8_WAIT_L(0); PG8_MMA(0, 1, At, B1); PG8_BAR;
            PG8_LDA(At, 0, 1); PG8_STAGE(PG8_SA(0, 0), a2, voffA);
            PG8_BAR; PG8_WAIT_L(0); PG8_MMA(1, 0, At, B0); PG8_BAR; PG8_SCHED;
            PG8_STAGE(PG8_SB(0, 1), b2 + hstepB, voffB);
            PG8_WAIT_V(6); PG8_BAR; PG8_MMA(1, 1, At, B1); PG8_BAR;
            PG8_LDB(B0, 1, 0); PG8_SCHED; PG8_LDA(At, 1, 0); PG8_STAGE(PG8_SA(0, 1), a2 + hstep, voffA);
            PG8_WAIT_L(8); PG8_BAR; PG8_WAIT_L(0); PG8_MMA(0, 0, At, B0); PG8_BAR; PG8_SCHED;
            PG8_LDB(B1, 1, 1); PG8_STAGE(PG8_SB(1, 0), b3, voffB);
            PG8_BAR; PG8_WAIT_L(0); PG8_MMA(0, 1, At, B1); PG8_BAR;
            PG8_LDA(At, 1, 1); PG8_STAGE(PG8_SA(1, 0), a3, voffA);
            PG8_BAR; PG8_WAIT_L(0); PG8_MMA(1, 0, At, B0); PG8_BAR; PG8_SCHED;
            PG8_STAGE(PG8_SB(1, 1), b3 + hstepB, voffB);
            PG8_WAIT_V(6); PG8_BAR; PG8_MMA(1, 1, At, B1); PG8_BAR;
            }
        }
        if constexpr (ALIGN_EPI) { if (wr == 0) PG8_BAR; }
        if constexpr (!Epi::AFTER_DRAIN) { E(acc, cur, wr, wc, fr, fq); S.done(cur); }
        if (!has_next) break;
#pragma unroll
        for (int a = 0; a < 2; ++a)
#pragma unroll
            for (int b = 0; b < 2; ++b)
#pragma unroll
                for (int m = 0; m < 4; ++m)
#pragma unroll
                    for (int n = 0; n < 2; ++n) acc[a][b][m][n] = (f32x4){0.f, 0.f, 0.f, 0.f};
        cur = nxt; cA = nA; cB = nB; ++ui;
        if constexpr (ALIGN_EPI) { if (wr == 1) PG8_BAR; }
    }
    PG8_WAIT_V(0);
    if constexpr (!ALIGN_EPI) { if (wr == 0) PG8_BAR; }
    PG8_BAR;
    if constexpr (Epi::AFTER_DRAIN) { E.fused(acc, cur, wr, wc, fr, fq, lds, wid, lane); S.done(cur); }
#undef PG8_SA
#undef PG8_SB
#undef PG8_STAGE
#undef PG8_LDA
#undef PG8_LDB
#undef PG8_MMA
#undef PG8_WAIT_V
#undef PG8_WAIT_L
#undef PG8_BAR
#undef PG8_SCHED
}
}
#endif
#ifndef EMU
#define XB_TMO      128
#define XB_XCNT(j)  (256  + 64 * (j))
#define XB_XSUB(j)  (1280 + 64 * (j))
#define XB_XGEN(j)  (2304 + 64 * (j))
#define XB_TOP      3328
#define XB_TOPGEN   3392
#define XCD_BAR_WORDS 3456
#define XB_SPIN_CAP (1u << 18)

__device__ __forceinline__ unsigned xb_ld(unsigned* p)              { return __hip_atomic_load(p, __ATOMIC_RELAXED, __HIP_MEMORY_SCOPE_AGENT); }
__device__ __forceinline__ unsigned xb_add(unsigned* p, unsigned v) { return __hip_atomic_fetch_add(p, v, __ATOMIC_RELAXED, __HIP_MEMORY_SCOPE_AGENT); }
__device__ __forceinline__ unsigned xb_xcc_id() { return (unsigned)__builtin_amdgcn_s_getreg((3 << 11) | 20) & 0xFu; }
#define XB_SPIN(cond, bar) do { unsigned _sp = 0; while (cond) { __builtin_amdgcn_s_sleep(1); \
    if ((++_sp & 255u) == 0u) { if (xb_ld(&(bar)[XB_TMO])) break; if (_sp > XB_SPIN_CAP) { atomicAdd(&(bar)[XB_TMO], 1u); break; } } } } while (0)

struct XcdBarrier {
    int wv;
    unsigned* bar; unsigned x;
    volatile LAS unsigned* st;
};

__device__ __forceinline__ XcdBarrier xcd_barrier_post(unsigned* bar, volatile LAS unsigned* st) {
    XcdBarrier b; b.wv = __builtin_amdgcn_readfirstlane(threadIdx.x >> 6); b.bar = bar; b.x = xb_xcc_id(); b.st = st;
    if (threadIdx.x == 0) (void)xb_add(&bar[XB_XCNT(b.x)], 1u);
    return b;
}
__device__ __forceinline__ void xcd_barrier_complete(unsigned* bar, unsigned x, unsigned& nloc, unsigned& nx) {
    const unsigned G = gridDim.x * gridDim.y * gridDim.z;
    unsigned sum, cnt, mine, sp = 0u;
    for (;;) {
        sum = 0u; cnt = 0u; mine = 0u;
#pragma unroll
        for (unsigned j = 0; j < 16; ++j) { const unsigned c = xb_ld(&bar[XB_XCNT(j)]); sum += c; cnt += (c > 0u) ? 1u : 0u; mine = (j == x) ? c : mine; }
        if (sum == G) break;
        __builtin_amdgcn_s_sleep(1);
        if ((++sp & 255u) == 0u) { if (xb_ld(&bar[XB_TMO])) break; if (sp > XB_SPIN_CAP) { atomicAdd(&bar[XB_TMO], 1u); break; } }
    }
    nloc = mine > 0u ? mine : 1u; nx = cnt > 0u ? cnt : 1u;
}

__device__ __forceinline__ void xcd_barrier(const XcdBarrier& b) {
    asm volatile("s_waitcnt vmcnt(0)" ::: "memory");
    __syncthreads();
    if (b.wv == 0 && lane_id() == 0) {
        unsigned* bar = b.bar;
        __builtin_amdgcn_s_waitcnt(0);
        unsigned nloc = b.st[0], nx = b.st[1];
        if (nloc == 0u) { xcd_barrier_complete(bar, b.x, nloc, nx); b.st[0] = nloc; b.st[1] = nx; }
        const unsigned old = xb_add(&bar[XB_XSUB(b.x)], 1u);
        const unsigned gen = old / nloc;
        if (old + 1u == (gen + 1u) * nloc) {
            __builtin_amdgcn_fence(__ATOMIC_RELEASE, "agent");
            asm volatile("s_waitcnt vmcnt(0)" ::: "memory");
            const unsigned og = xb_add(&bar[XB_TOP], 1u);
            const unsigned tg = og / nx;
            if (og + 1u == (tg + 1u) * nx) xb_add(&bar[XB_TOPGEN], 1u);
            else XB_SPIN(xb_ld(&bar[XB_TOPGEN]) == tg, bar);
            __builtin_amdgcn_fence(__ATOMIC_ACQUIRE, "agent");
            xb_add(&bar[XB_XGEN(b.x)], 1u);
            asm volatile("s_waitcnt vmcnt(0)" ::: "memory");
        } else {
            XB_SPIN(xb_ld(&bar[XB_XGEN(b.x)]) == gen, bar);
            __builtin_amdgcn_fence(__ATOMIC_ACQUIRE, "agent");
            asm volatile("s_waitcnt vmcnt(0)" ::: "memory");
        }
    }
    __syncthreads();
}

__device__ __forceinline__ void sub_barrier(unsigned* ctr, unsigned n, unsigned* tmo, bool leader) {
    asm volatile("s_waitcnt vmcnt(0)" ::: "memory");
    __syncthreads();
    if (leader) {
        __builtin_amdgcn_s_waitcnt(0);
        __builtin_amdgcn_fence(__ATOMIC_RELEASE, "agent");
        asm volatile("s_waitcnt vmcnt(0)" ::: "memory");
        (void)xb_add(ctr, 1u);
        unsigned sp = 0u;
        while (xb_ld(ctr) < n) { __builtin_amdgcn_s_sleep(1); if ((++sp & 255u) == 0u) { if (xb_ld(tmo)) break; if (sp > XB_SPIN_CAP) { atomicAdd(tmo, 1u); break; } } }
        __builtin_amdgcn_fence(__ATOMIC_ACQUIRE, "agent");
        asm volatile("s_waitcnt vmcnt(0)" ::: "memory");
    }
    __syncthreads();
}
#endif
DEV void p0_transpose_item(const float* W, int K, int N, int src_n0, bf16* WT, int dst_n0, LAS float* scr, int kb, int lane, const float* gain) {
    const int k0 = 64 * kb;
    if ((((size_t)W) & 15) == 0 && (N & 3) == 0 && (src_n0 & 3) == 0) {
        f32x4 v[8];
#pragma unroll
        for (int i = 0; i < 8; ++i) v[i] = *(const f32x4*)(W + (size_t)(k0 + 8 * i + (lane >> 3)) * N + src_n0 + 4 * (lane & 7));
#pragma unroll
        for (int i = 0; i < 8; ++i) { const int kk = 8 * i + (lane >> 3); const float gk = gain ? gain[k0 + kk] : 1.f;
#pragma unroll
            for (int j = 0; j < 4; ++j) scr[kk * 33 + 4 * (lane & 7) + j] = v[i][j] * gk; }
    } else {
#pragma unroll 8
        for (int i = 0; i < 32; ++i) { const int kk = 2 * i + (lane >> 5); scr[kk * 33 + (lane & 31)] = W[(size_t)(k0 + kk) * N + src_n0 + (lane & 31)] * (gain ? gain[k0 + kk] : 1.f); }
    }
    wave_sync();
    const int c = lane & 7;
#pragma unroll
    for (int j = 0; j < 4; ++j) { const int n = (lane >> 3) + 8 * j; const LAS float* s = scr + (8 * c) * 33 + n;
        u32x4 o; o.x = pk2(s[0 * 33], s[1 * 33]); o.y = pk2(s[2 * 33], s[3 * 33]); o.z = pk2(s[4 * 33], s[5 * 33]); o.w = pk2(s[6 * 33], s[7 * 33]);
        *(u32x4*)(WT + (size_t)(dst_n0 + n) * K + k0 + 8 * c) = o; }
    wave_sync();
}
DEV int p0_first(int gw, int NGW, int base) { return (gw + NGW - base % NGW) % NGW; }
DEV void p0_transpose_seg(const float* W, int K, int N, int src_n0, int nseg, bf16* WT, int dst_n0, LAS float* scr, int gw, int NGW, int lane, int& base, const float* gain = nullptr) {
    const int nkb = K / 64, nnb = nseg / 32; const int g0 = p0_first(gw, NGW, base); base += nkb * nnb;
    for (int it = g0; it < nkb * nnb; it += NGW) { const int kb = it / nnb, nb = it % nnb; p0_transpose_item(W, K, N, src_n0 + 32 * nb, WT, dst_n0 + 32 * nb, scr, kb, lane, gain); }
}
DEV void rms_row_to_bf16(const float* xrow, const float* w, bf16* orow, int lane) {
    const f32x4* xr = (const f32x4*)xrow + lane; const f32x4* wr = (const f32x4*)w + lane;
    f32x4 v[4]; float s = 0.f;
#pragma unroll
    for (int j = 0; j < 4; ++j) { v[j] = xr[64 * j]; s += (v[j][0] * v[j][0] + v[j][1] * v[j][1]) + (v[j][2] * v[j][2] + v[j][3] * v[j][3]); }
    const float rstd = 1.f / sqrtf(wave_sum(s) * (1.f / D) + EPS);
    u32x2* o8 = (u32x2*)orow + lane;
#pragma unroll
    for (int j = 0; j < 4; ++j) { const f32x4 g = wr[64 * j]; u32x2 o; o.x = pk2(v[j][0] * rstd * g[0], v[j][1] * rstd * g[1]); o.y = pk2(v[j][2] * rstd * g[2], v[j][3] * rstd * g[3]); o8[64 * j] = o; }
}
DEV void rms_row_to_f32(const bf16* xrow, const float* w, float* orow, int lane) {
    const u32x2* xr = (const u32x2*)xrow + lane; const f32x4* wr = (const f32x4*)w + lane;
    f32x4 v[4]; float s = 0.f;
#pragma unroll
    for (int j = 0; j < 4; ++j) { const u32x2 t = xr[64 * j]; v[j] = (f32x4){bflo(t.x), bfhi(t.x), bflo(t.y), bfhi(t.y)}; s += (v[j][0] * v[j][0] + v[j][1] * v[j][1]) + (v[j][2] * v[j][2] + v[j][3] * v[j][3]); }
    const float rstd = 1.f / sqrtf(wave_sum(s) * (1.f / D) + EPS);
    f32x4* o = (f32x4*)orow + lane;
#pragma unroll
    for (int j = 0; j < 4; ++j) { const f32x4 g = wr[64 * j]; o[64 * j] = v[j] * rstd * g; }
}
DEV void phase_norm_bf16(const float* x, const float* w, bf16* out, int rows, int gw, int NGW, int lane, int& base) {
    const int g0 = p0_first(gw, NGW, base); base += rows;
    for (int m = g0; m < rows; m += NGW) rms_row_to_bf16(x + (size_t)m * D, w, out + (size_t)m * D, lane);
}

struct P0Args { const float* w_in; const float* w_out; const float* w_xq; const float* w_xkv; const float* w_xo; const float* w_ff1; const float* w_ff2;
                const float* x; const float* mem; const float* norm_mix_w; const float* norm_mem_w; const float* norm_xa_w; const float* norm_ffn_w; };
DEV void phase_prologue(const P0Args& a, unsigned char* ws, unsigned char* pro, LAS float* scr, int gw, int NGW, int lane) {
    int base = 0;
    for (int l = 0; l < DEPTH; ++l) {
        const float* win = a.w_in + (size_t)l * D * 3752; bf16* wint = (bf16*)(ws + WS_WIN) + (size_t)l * NPROJ * D;
        const float* gmix = a.norm_mix_w + (size_t)l * D;
        p0_transpose_seg(win, D, 3752, 0, 1152, wint, 0, scr, gw, NGW, lane, base, gmix);
        p0_transpose_seg(win, D, 3752, 1152, 1024, wint, 1280, scr, gw, NGW, lane, base, gmix);
        p0_transpose_seg(win, D, 3752, 2192, 1536, wint, 2304, scr, gw, NGW, lane, base, gmix);
        for (int r = p0_first(gw, NGW, base); r < 128; r += NGW) { const int g = r; int src = -1;
            if (g < 8) src = 2176 + g; else if (g < 16) src = 2184 + (g - 8); else if (g < 28) src = 3728 + (g - 16); else if (g < 40) src = 3740 + (g - 28);
            bf16* dst = wint + (size_t)(1152 + r) * D;
            for (int k = lane; k < D; k += 64) dst[k] = (bf16)(src >= 0 ? f2bf(win[(size_t)k * 3752 + src] * gmix[k]) : 0u); }
        base += 128;
        p0_transpose_seg(a.w_out + (size_t)l * D * D, D, D, 0, D, (bf16*)(ws + WS_WOUT) + (size_t)l * D * D, 0, scr, gw, NGW, lane, base);
        { const float* wq = a.w_xq + (size_t)l * D * D; const float* gx = a.norm_xa_w + (size_t)l * D; bf16* wqb = (bf16*)(ws + WS_WXQ) + (size_t)l * D * D;
          for (int c = p0_first(gw, NGW, base); c < D; c += NGW) { const float g = gx[c] * 0.0625f; const f32x4* src = (const f32x4*)(wq + (size_t)c * D + 16 * lane);
              const f32x4 v0 = src[0] * g, v1 = src[1] * g, v2 = src[2] * g, v3 = src[3] * g;
              u32x4 o0, o1; o0.x = pk2(v0[0], v0[1]); o0.y = pk2(v0[2], v0[3]); o0.z = pk2(v1[0], v1[1]); o0.w = pk2(v1[2], v1[3]); o1.x = pk2(v2[0], v2[1]); o1.y = pk2(v2[2], v2[3]); o1.z = pk2(v3[0], v3[1]); o1.w = pk2(v3[2], v3[3]);
              u32x4* dst = (u32x4*)(wqb + ((size_t)(lane >> 4) * D + c) * 256 + 16 * (lane & 15)); dst[0] = o0; dst[1] = o1; } base += D; }
        for (int h = 0; h < 4; ++h) p0_transpose_seg(a.w_xo + (size_t)l * D * D + (size_t)h * 256 * D, 256, D, 0, D, (bf16*)(ws + WS_WXO) + (size_t)l * D * D + (size_t)h * D * 256, 0, scr, gw, NGW, lane, base);
        p0_transpose_seg(a.w_xkv + (size_t)l * D * 2048, D, 2048, 0, 2048, (bf16*)(pro + PRO_WXKV) + (size_t)l * 2048 * D, 0, scr, gw, NGW, lane, base);
        p0_transpose_seg(a.w_ff1 + (size_t)l * D * FF, D, FF, 0, FF, (bf16*)(ws + WS_W1) + (size_t)l * FF * D, 0, scr, gw, NGW, lane, base, a.norm_ffn_w + (size_t)l * D);
        p0_transpose_seg(a.w_ff2 + (size_t)l * FF * D, FF, D, 0, D, (bf16*)(ws + WS_W2) + (size_t)l * D * FF, 0, scr, gw, NGW, lane, base);
        phase_norm_bf16(a.mem, a.norm_mem_w + (size_t)l * D, (bf16*)(pro + PRO_MEMN) + (size_t)l * NMEMROWS * D, NMEMROWS, gw, NGW, lane, base);
    }
    static_assert(T % 2 == 0, "row pairs");
    for (int m = 2 * gw; m < T; m += 2 * NGW) {
        f32x4 v[2][4];
#pragma unroll
        for (int r = 0; r < 2; ++r) { const f32x4* xr = (const f32x4*)(a.x + (size_t)(m + r) * D) + lane;
#pragma unroll
            for (int j = 0; j < 4; ++j) v[r][j] = xr[64 * j]; }
#pragma unroll
        for (int r = 0; r < 2; ++r) { u32x2* o8 = (u32x2*)((bf16*)(ws + WS_XY) + (size_t)(m + r) * D) + lane; float s = 0.f;
#pragma unroll
            for (int j = 0; j < 4; ++j) { const f32x4 t = v[r][j]; u32x2 o; o.x = pk2(t[0], t[1]); o.y = pk2(t[2], t[3]); o8[64 * j] = o;
                const f32x4 q = {bflo(o.x), bfhi(o.x), bflo(o.y), bfhi(o.y)}; s += (q[0] * q[0] + q[1] * q[1]) + (q[2] * q[2] + q[3] * q[3]); }
            s = wave_sum(s); if (lane < 4) ((float*)(ws + WS_RSS))[(size_t)(m + r) * 4 + lane] = (lane == 0) ? s : 0.f; } }
}

DEV void phase_na(const bf16* __restrict__ nab, const LAS float* biasL  , bf16* __restrict__ xy, int gw, int NGW, int lane) {
    const int fr = lane & 15, fq = lane >> 4;
    for (int it = gw; it < (T / 16) * 6; it += NGW) {
        const int h = it % 6, tg = it / 6, token0 = tg * 16, b = token0 / SEQ, s0 = token0 % SEQ, r = s0 / 64, g = (s0 % 64) / 16;
        int r0 = r - 4; r0 = r0 < 0 ? 0 : (r0 > GROWS - 8 ? GROWS - 8 : r0);
        const int cbase = (g == 0) ? 0 : (g == 1 ? 8 : (g == 2 ? 24 : 32));
        const int c = 16 * g + fr; int c0 = c - 8; c0 = c0 < 0 ? 0 : (c0 > 48 ? 48 : c0);
        const bf16* qp = nab + (size_t)(token0 + fr) * NAB_LD + h * 64 + 8 * fq;
        const bf16x8 q0 = ldfrag(qp), q1 = ldfrag(qp + 32);
        f32x4 acc[16];
#pragma unroll
        for (int kt = 0; kt < 16; ++kt) { const int i = kt >> 1, cb = kt & 1;
            const bf16* kp = nab + (size_t)(b * SEQ + (r0 + i) * 64 + cbase + 16 * cb + fr) * NAB_LD + 384 + h * 64 + 8 * fq;
            f32x4 a = {0.f, 0.f, 0.f, 0.f}; a = mfma16(ldfrag(kp), q0, a); a = mfma16(ldfrag(kp + 32), q1, a); acc[kt] = a; }
        float mx = -1e30f;
#pragma unroll
        for (int kt = 0; kt < 16; ++kt) { const int i = kt >> 1, cb = kt & 1; const int dr = r0 + i - r + 7;
#pragma unroll
            for (int j = 0; j < 4; ++j) { const int kc = cbase + 16 * cb + 4 * fq + j; const bool ok = (kc >= c0) && (kc < c0 + 16);
                float x = -1e30f; if (ok) x = acc[kt][j] * 0.125f + biasL[(h * 15 + dr) * 31 + (kc - c + 15)];
                acc[kt][j] = x; mx = fmaxf(mx, x); } }
        mx = fmaxf(mx, shfl_xor_f(mx, 16)); mx = fmaxf(mx, shfl_xor_f(mx, 32));
        float sum = 0.f;
#pragma unroll
        for (int kt = 0; kt < 16; ++kt)
#pragma unroll
            for (int j = 0; j < 4; ++j) { const float p = (acc[kt][j] > -1e29f) ? expf(acc[kt][j] - mx) : 0.f; acc[kt][j] = p; sum += p; }
        sum += shfl_xor_f(sum, 16); sum += shfl_xor_f(sum, 32);
        const float inv = 1.f / sum;
        f32x4 o[4];
#pragma unroll
        for (int dt = 0; dt < 4; ++dt) o[dt] = (f32x4){0.f, 0.f, 0.f, 0.f};
#pragma unroll
        for (int i = 0; i < 8; ++i) { const bf16x8 pf = pack8(acc[2 * i], acc[2 * i + 1]);
            const bf16* vrow = nab + (size_t)(b * SEQ + (r0 + i) * 64 + cbase + 4 * fq) * NAB_LD + 768 + h * 64 + fr;
#pragma unroll
            for (int dt = 0; dt < 4; ++dt) { u32 w[4];
#pragma unroll
                for (int jj = 0; jj < 4; ++jj) { const int j0 = 2 * jj, j1 = 2 * jj + 1;
                    const u32 lo = vrow[(size_t)(16 * (j0 >> 2) + (j0 & 3)) * NAB_LD + 16 * dt], hi = vrow[(size_t)(16 * (j1 >> 2) + (j1 & 3)) * NAB_LD + 16 * dt]; w[jj] = lo | (hi << 16); }
                u32x4 wv; wv.x = w[0]; wv.y = w[1]; wv.z = w[2]; wv.w = w[3];
                o[dt] = mfma16(__builtin_bit_cast(bf16x8, wv), pf, o[dt]); } }
        bf16* op = xy + (size_t)(token0 + fr) * D + h * 64 + 4 * fq;
#pragma unroll
        for (int dt = 0; dt < 4; ++dt) { u32x2 w; w.x = pk2(o[dt][0] * inv, o[dt][1] * inv); w.y = pk2(o[dt][2] * inv, o[dt][3] * inv); *(u32x2*)(op + 16 * dt) = w; }
    }
}

constexpr int NA_STRIPS = 5, NA_BIAS_OFF = RING_BYTES, NA_XO_OFF = WSM_OFF  , NA_XS_OFF = MISC_OFF + 256  ;
static_assert(NA_BIAS_OFF + 15 * 32 * 4 <= NA_XO_OFF && NA_XO_OFF + 8192 <= MISC_OFF && NA_XS_OFF + 2048 <= LDS_BYTES, "NA LDS extras");
DEV int na_r0(int r) { int r0 = r - 4; return r0 < 0 ? 0 : (r0 > GROWS - 8 ? GROWS - 8 : r0); }
DEV void na_row_issue(u32x4 (&r)[2], const bf16* __restrict__ nab, int b, int h, int R, int tid) {
    const int col = tid >> 3, ck = tid & 7; const bf16* p = nab + ((size_t)b * SEQ + R * 64 + col) * NAB_LD + h * 64 + ck * 8; r[0] = ld16(p + 384); r[1] = ld16(p + 768);
}
DEV void na_row_commit(const u32x4 (&r)[2], LAS unsigned char* lds, int R, int tid) {
    const int col = tid >> 3, ck = tid & 7; const int off = (R & 7) * 8192 + col * 128 + ((ck ^ (col & 7)) << 4); *(LAS u32x4*)(lds + off) = r[0]; *(LAS u32x4*)(lds + 65536 + off) = r[1];
}
DEV void na_half(const bf16x8 qa, const bf16x8 qb, const LAS unsigned char* lds, const LAS unsigned char* biasH  , const int (&boff)[8], int r, int g, int hf, int lane,
                 float& mx_out, float& sum_out, f32x4 (&o)[4]) {
    const int fr = lane & 15, fq = lane >> 4;
    const int cbase = (g == 0) ? 0 : (g == 1 ? 8 : (g == 2 ? 24 : 32));
    const int r0 = na_r0(r);
    const int colk = cbase + fr, koff0 = colk * 128 + ((fq ^ (colk & 7)) << 4), koff1 = koff0 ^ 64;
    f32x4 acc[8];
#pragma unroll
    for (int ii = 0; ii < 4; ++ii) { const int so = ((r0 + 4 * hf + ii) & 7) * 8192;
        const LAS unsigned char* k0p = lds + so + koff0; const LAS unsigned char* k1p = lds + so + koff1;
#pragma unroll
        for (int cb = 0; cb < 2; ++cb) { f32x4 a = {0.f, 0.f, 0.f, 0.f};
            a = mfma16(*(const LAS bf16x8*)(k0p + 2048 * cb), qa, a); a = mfma16(*(const LAS bf16x8*)(k1p + 2048 * cb), qb, a); acc[2 * ii + cb] = a; } }
    float mx = -1e30f;
    const int drb = (r0 + 4 * hf - r + 7) * 128;
#pragma unroll
    for (int kt = 0; kt < 8; ++kt)
#pragma unroll
        for (int j = 0; j < 4; ++j) { const float x = acc[kt][j] * 0.125f + *(const LAS float*)(biasH + drb + (kt >> 1) * 128 + boff[4 * (kt & 1) + j]); acc[kt][j] = x; mx = fmaxf(mx, x); }
    mx = fmaxf(mx, shfl_xor_f(mx, 16)); mx = fmaxf(mx, shfl_xor_f(mx, 32));
    float sum = 0.f;
#pragma unroll
    for (int kt = 0; kt < 8; ++kt)
#pragma unroll
        for (int j = 0; j < 4; ++j) { const float p = fexp(acc[kt][j] - mx); acc[kt][j] = p; sum += p; }
    sum += shfl_xor_f(sum, 16); sum += shfl_xor_f(sum, 32);
#pragma unroll
    for (int dt = 0; dt < 4; ++dt) o[dt] = (f32x4){0.f, 0.f, 0.f, 0.f};
    const int kc1 = cbase + 4 * fq + (fr >> 2), pp = fr & 3;
    const int voff0 = 65536 + kc1 * 128 + ((pp & 1) << 3) + (((pp >> 1) ^ (kc1 & 7)) << 4);
#pragma unroll
    for (int ii = 0; ii < 4; ++ii) { const bf16x8 pf = pack8(acc[2 * ii], acc[2 * ii + 1]); const int so = ((r0 + 4 * hf + ii) & 7) * 8192;
#pragma unroll
        for (int dt = 0; dt < 4; ++dt) { const LAS unsigned char* vp = lds + so + (voff0 ^ (dt << 5));
            o[dt] = mfma16(frag2(lds_tr4(vp), lds_tr4(vp + 2048)), pf, o[dt]); } }
    mx_out = mx; sum_out = sum;
}
DEV void phase_na2(const bf16* __restrict__ nab, const float* __restrict__ relbias  , bf16* __restrict__ xy, LAS unsigned char* lds, int bid, int G, int tid) {
    const int wave = rfl(tid >> 6), lane = tid & 63, fr = lane & 15, fq = lane >> 4; const int g = wave & 3, hf = wave >> 2;
    LAS float* biasH = (LAS float*)(lds + NA_BIAS_OFF);
    LAS u32* xo_ = (LAS u32*)(lds + NA_XO_OFF); LAS float* xs_ = (LAS float*)(lds + NA_XS_OFF);
    for (int un = bid; un < BATCH * 6 * NA_STRIPS; un += G) {
        const int st = un % NA_STRIPS, bh = un / NA_STRIPS, h = bh % 6, b = bh / 6, ra = (st * GROWS) / NA_STRIPS, rb = ((st + 1) * GROWS) / NA_STRIPS;
        for (int i = tid; i < 15 * 32; i += NWAVES * 64) biasH[i] = ((i & 31) < 31) ? relbias[h * 465 + (i >> 5) * 31 + (i & 31)] : -1e30f;
        { const int r0 = na_r0(ra);
#pragma unroll 1
          for (int hh = 0; hh < 2; ++hh) { u32x4 kv[8];
#pragma unroll
              for (int i = 0; i < 4; ++i) { const int R = r0 + 4 * hh + i, col = tid >> 3, ck = tid & 7; const bf16* p = nab + ((size_t)b * SEQ + R * 64 + col) * NAB_LD + h * 64 + ck * 8; kv[i] = ld16(p + 384); kv[4 + i] = ld16(p + 768); }
#pragma unroll
              for (int i = 0; i < 4; ++i) { const int R = r0 + 4 * hh + i, col = tid >> 3, ck = tid & 7; const int off = (R & 7) * 8192 + col * 128 + ((ck ^ (col & 7)) << 4);
                  *(LAS u32x4*)(lds + off) = kv[i]; *(LAS u32x4*)(lds + 65536 + off) = kv[4 + i]; } } }
#define NA_NEED(r) (((r) + 1 < rb) && (na_r0((r) + 1) != na_r0(r)))
#define NA_QLOAD(qx0, qx1, r) do { const bf16* qp_ = nab + ((size_t)b * SEQ + (r) * 64 + 16 * g + fr) * NAB_LD + h * 64 + 8 * fq; qx0 = ldfrag(qp_); qx1 = ldfrag(qp_ + 32); } while (0)
#define NA_STEP(r, Q0, Q1, NCUR, NNXT) { \
            if (NA_NEED((r) + 1)) na_row_issue(NNXT, nab, b, h, na_r0((r) + 2) + 7, tid); \
            float mx_, sm_; f32x4 o_[4]; na_half(Q0, Q1, lds, biasB, boff, (r), g, hf, lane, mx_, sm_, o_); \
            if ((r) + 2 < rb) NA_QLOAD(Q0, Q1, (r) + 2); \
            if (hf) { _Pragma("unroll") for (int dt = 0; dt < 4; ++dt) { xo_[((g * 8 + 2 * dt) * 64) + lane] = pk2(o_[dt][0], o_[dt][1]); xo_[((g * 8 + 2 * dt + 1) * 64) + lane] = pk2(o_[dt][2], o_[dt][3]); } \
                      xs_[(g * 2) * 64 + lane] = mx_; xs_[(g * 2 + 1) * 64 + lane] = sm_; } \
            lds_barrier();                                                                     \
            if (!hf) { const float m1 = xs_[(g * 2) * 64 + lane], s1 = xs_[(g * 2 + 1) * 64 + lane]; const float M = fmaxf(mx_, m1), a0 = fexp(mx_ - M), a1 = fexp(m1 - M), inv = frcp(sm_ * a0 + s1 * a1); \
                bf16* op = xy + ((size_t)b * SEQ + (r) * 64 + 16 * g + fr) * D + h * 64 + 4 * fq; \
                _Pragma("unroll") for (int dt = 0; dt < 4; ++dt) { const u32 w0 = xo_[((g * 8 + 2 * dt) * 64) + lane], w1 = xo_[((g * 8 + 2 * dt + 1) * 64) + lane]; \
                    u32x2 w; w.x = pk2((o_[dt][0] * a0 + bflo(w0) * a1) * inv, (o_[dt][1] * a0 + bfhi(w0) * a1) * inv); w.y = pk2((o_[dt][2] * a0 + bflo(w1) * a1) * inv, (o_[dt][3] * a0 + bfhi(w1) * a1) * inv); \
                    *(u32x2*)(op + 16 * dt) = w; } } \
            if (NA_NEED(r)) na_row_commit(NCUR, lds, na_r0((r) + 1) + 7, tid); \
            lds_barrier(); }
        u32x4 nA[2], nB[2]; bf16x8 qA0, qA1, qB0, qB1; int boff[8];
        { const int cbase = (g == 0) ? 0 : (g == 1 ? 8 : (g == 2 ? 24 : 32)); const int c = 16 * g + fr; int c0 = c - 8; c0 = c0 < 0 ? 0 : (c0 > 48 ? 48 : c0);
#pragma unroll
          for (int t = 0; t < 8; ++t) { const int kc = cbase + 16 * (t >> 2) + 4 * fq + (t & 3); boff[t] = 4 * ((kc >= c0 && kc < c0 + 16) ? (kc - c + 15) : 31); } }
        if (NA_NEED(ra)) na_row_issue(nA, nab, b, h, na_r0(ra + 1) + 7, tid);
        NA_QLOAD(qA0, qA1, ra); if (ra + 1 < rb) NA_QLOAD(qB0, qB1, ra + 1);
        lds_barrier();
        const LAS unsigned char* biasB = (const LAS unsigned char*)biasH;
        for (int r = ra; r < rb; r += 2) {
            NA_STEP(r, qA0, qA1, nA, nB)
            if (r + 1 >= rb) break;
            NA_STEP(r + 1, qB0, qB1, nB, nA)
        }
#undef NA_STEP
#undef NA_NEED
#undef NA_QLOAD
    }
}
DEV int ml_item(int b, int h, int dir, int n) { return ((b * 4 + h) * 2 + dir) * NC + n; }
DEV void ml_gates(const float* gates, const float* i_bias, const float* f_bias, int b, int h, int dir, int chunk, int lane, float& bcum, float& ig) {
    const int tok = b * SEQ + chunk * 64 + (dir ? 63 - lane : lane);
    const float fpre = gates[(size_t)tok * GATES_LD + 8 + dir * 4 + h] + f_bias[dir * 4 + h];
    ig = gates[(size_t)tok * GATES_LD + dir * 4 + h] + i_bias[dir * 4 + h];
    bcum = wave_incl_scan(logsigmoidf_(fpre), lane);
}
DEV void phase_ml1(const bf16* mlb, const float* gates, const float* i_bias, const float* f_bias, bf16* cml, float* nml, float* sml, LAS float* wsm, int gw, int NGW, int lane) {
    const int fr = lane & 15, fq = lane >> 4;
    for (int it = gw; it < NITEM_ML; it += NGW) {
        const int dir = it & 1, chunk = (it >> 1) % NC, bh = it / (2 * NC), h = bh & 3, b = bh >> 2, n = dir ? NC - 1 - chunk : chunk;
        float bcum, ig; ml_gates(gates, i_bias, f_bias, b, h, dir, chunk, lane, bcum, ig);
        const float blast = lane63_f(bcum), w = blast - bcum + ig, mloc = wave_max(w);
        wave_sync(); wsm[lane] = expf(w - mloc) * 0.125f; wave_sync();
        const size_t tok0 = (size_t)b * SEQ + chunk * 64;
        bf16x8 af[4][2];
#pragma unroll
        for (int lb = 0; lb < 2; ++lb) { float ws[8]; size_t rowoff[8];
#pragma unroll
            for (int j = 0; j < 8; ++j) { const int lp = 32 * lb + 8 * fq + j; ws[j] = wsm[lp]; rowoff[j] = (tok0 + (dir ? 63 - lp : lp)) * MLB_LD; }
#pragma unroll
            for (int dt = 0; dt < 4; ++dt) { u32 wv[4];
#pragma unroll
                for (int jj = 0; jj < 4; ++jj) { const float lo = bf2f(mlb[rowoff[2 * jj] + 256 + h * 64 + 16 * dt + fr]) * ws[2 * jj], hi = bf2f(mlb[rowoff[2 * jj + 1] + 256 + h * 64 + 16 * dt + fr]) * ws[2 * jj + 1]; wv[jj] = pk2(lo, hi); }
                u32x4 t; t.x = wv[0]; t.y = wv[1]; t.z = wv[2]; t.w = wv[3]; af[dt][lb] = __builtin_bit_cast(bf16x8, t); } }
        f32x4 cacc[4][4], nacc[4];
#pragma unroll
        for (int dt = 0; dt < 4; ++dt) { nacc[dt] = (f32x4){0.f, 0.f, 0.f, 0.f};
#pragma unroll
            for (int et = 0; et < 4; ++et) cacc[dt][et] = (f32x4){0.f, 0.f, 0.f, 0.f}; }
        const u32 one2 = (fr == 0) ? 0x3f803f80u : 0u; u32x4 onev; onev.x = one2; onev.y = one2; onev.z = one2; onev.w = one2; const bf16x8 bone = __builtin_bit_cast(bf16x8, onev);
#pragma unroll
        for (int lb = 0; lb < 2; ++lb) {
#pragma unroll
            for (int et = 0; et < 4; ++et) { u32 wv[4];
#pragma unroll
                for (int jj = 0; jj < 4; ++jj) { const int l0 = 32 * lb + 8 * fq + 2 * jj, l1 = l0 + 1;
                    const u32 lo = mlb[(tok0 + (dir ? 63 - l0 : l0)) * MLB_LD + 512 + h * 64 + 16 * et + fr], hi = mlb[(tok0 + (dir ? 63 - l1 : l1)) * MLB_LD + 512 + h * 64 + 16 * et + fr]; wv[jj] = lo | (hi << 16); }
                u32x4 t; t.x = wv[0]; t.y = wv[1]; t.z = wv[2]; t.w = wv[3]; const bf16x8 bf = __builtin_bit_cast(bf16x8, t);
#pragma unroll
                for (int dt = 0; dt < 4; ++dt) cacc[dt][et] = mfma16(af[dt][lb], bf, cacc[dt][et]); }
#pragma unroll
            for (int dt = 0; dt < 4; ++dt) nacc[dt] = mfma16(af[dt][lb], bone, nacc[dt]); }
        const size_t iti = (size_t)ml_item(b, h, dir, n);
        bf16* cp = cml + iti * 4096;
#pragma unroll
        for (int dt = 0; dt < 4; ++dt)
#pragma unroll
            for (int et = 0; et < 4; ++et) { u32x2 w; w.x = pk2(cacc[dt][et][0], cacc[dt][et][1]); w.y = pk2(cacc[dt][et][2], cacc[dt][et][3]); *(u32x2*)(cp + (16 * et + fr) * 64 + 16 * dt + 4 * fq) = w; }
        if (fr == 0) {
#pragma unroll
            for (int dt = 0; dt < 4; ++dt) *(f32x4*)(nml + iti * 64 + 16 * dt + 4 * fq) = nacc[dt]; }
        if (lane == 0) { sml[iti * 4 + 0] = mloc; sml[iti * 4 + 1] = blast; }
    }
}
DEV void phase_ml2(bf16* cml, float* nml, float* sml, int gtid, int NGT) {
    constexpr int NCHAIN = BATCH * 4 * 2;
    for (int w = gtid; w < NCHAIN * 512 + NCHAIN * 16; w += NGT) {
        if (w < NCHAIN * 512) {
            const int chain = w >> 9, grp = w & 511; float c[8];
#pragma unroll
            for (int j = 0; j < 8; ++j) c[j] = 0.f;
            float m = 0.f;
            for (int n0 = 0; n0 < NC; n0 += 8) { u32x4 ld[8]; float mlv[8], blv[8];
#pragma unroll
                for (int u = 0; u < 8; ++u) { ld[u] = *(const u32x4*)(cml + ((size_t)(chain * NC + n0 + u)) * 4096 + grp * 8); mlv[u] = sml[((size_t)chain * NC + n0 + u) * 4]; blv[u] = sml[((size_t)chain * NC + n0 + u) * 4 + 1]; }
#pragma unroll
                for (int u = 0; u < 8; ++u) { const size_t it = (size_t)chain * NC + n0 + u; const float ml = mlv[u], bl = blv[u];
                    const float mn = fmaxf(bl + m, ml), a = expf(bl + m - mn), g = expf(ml - mn);
                    u32x4 o; o.x = pk2(c[0], c[1]); o.y = pk2(c[2], c[3]); o.z = pk2(c[4], c[5]); o.w = pk2(c[6], c[7]);
                    *(u32x4*)(cml + it * 4096 + grp * 8) = o;
                    const u32 lw[4] = {ld[u].x, ld[u].y, ld[u].z, ld[u].w};
#pragma unroll
                    for (int j = 0; j < 4; ++j) { c[2 * j] = a * c[2 * j] + g * bflo(lw[j]); c[2 * j + 1] = a * c[2 * j + 1] + g * bfhi(lw[j]); }
                    m = mn; } }
        } else {
            const int idx = w - NCHAIN * 512, chain = idx >> 4, grp = idx & 15; f32x4 nv = {0.f, 0.f, 0.f, 0.f}; float m = 0.f;
            for (int n = 0; n < NC; ++n) { const size_t it = (size_t)chain * NC + n; const float ml = sml[it * 4 + 0], bl = sml[it * 4 + 1];
                const float mn = fmaxf(bl + m, ml), a = expf(bl + m - mn), g = expf(ml - mn);
                const f32x4 nl = *(const f32x4*)(nml + it * 64 + grp * 4); *(f32x4*)(nml + it * 64 + grp * 4) = nv;
                if (grp == 0) sml[it * 4 + 2] = m;
                nv = nv * a + nl * g; m = mn; }
        }
    }
}
DEV void phase_ml3(const bf16* mlb, const float* gates, const float* i_bias, const float* f_bias, const float* norm_w, const bf16* cml, const float* nml, const float* sml,
                   bf16* xy, LAS float* hbuf  , LAS float* wsm  , int gw, int NGW, int lane) {
    for (int wi = gw; wi < BATCH * 4 * NC; wi += NGW) {
        int ln_ = lane;
#ifndef EMU
        asm volatile("" : "+v"(ln_));
#endif
        const int fr = ln_ & 15, fq = ln_ >> 4;
        const int chunk = wi % NC, bh = wi / NC, h = bh & 3, b = bh >> 2; const size_t tok0 = (size_t)b * SEQ + chunk * 64;
#pragma unroll 1
        for (int dir = 0; dir < 2; ++dir) {
            const int n = dir ? NC - 1 - chunk : chunk; const size_t it = (size_t)ml_item(b, h, dir, n);
            float bcum, ig; ml_gates(gates, i_bias, f_bias, b, h, dir, chunk, lane, bcum, ig);
            wave_sync(); wsm[lane] = bcum; wsm[64 + lane] = ig; wave_sync();
            const float mprev = sml[it * 4 + 2];
            bf16x8 kf[4][2], vf[4][2], nf[2], qf[4][2];
#pragma unroll
            for (int t4 = 0; t4 < 4; ++t4)
#pragma unroll
                for (int db = 0; db < 2; ++db) { const int sp = 16 * t4 + fr;
                    kf[t4][db] = ldfrag(mlb + (tok0 + (dir ? 63 - sp : sp)) * MLB_LD + 256 + h * 64 + 32 * db + 8 * fq);
                    qf[t4][db] = ldfrag(mlb + (tok0 + (dir ? 63 - sp : sp)) * MLB_LD + h * 64 + 32 * db + 8 * fq); }
#pragma unroll
            for (int db = 0; db < 2; ++db) { u32x4 t = {0u, 0u, 0u, 0u};
                if (fr == 0) { const f32x4 a = *(const f32x4*)(nml + it * 64 + 32 * db + 8 * fq), c = *(const f32x4*)(nml + it * 64 + 32 * db + 8 * fq + 4); t.x = pk2(a[0], a[1]); t.y = pk2(a[2], a[3]); t.z = pk2(c[0], c[1]); t.w = pk2(c[2], c[3]); }
                nf[db] = __builtin_bit_cast(bf16x8, t); }
#pragma unroll
            for (int sb = 0; sb < 2; ++sb) { size_t rowoff[8];
#pragma unroll
                for (int j = 0; j < 8; ++j) { const int sp = 32 * sb + 16 * (j >> 2) + 4 * fq + (j & 3); rowoff[j] = (tok0 + (dir ? 63 - sp : sp)) * MLB_LD + 512 + h * 64 + fr; }
#pragma unroll
                for (int et = 0; et < 4; ++et) { u32x4 t; t.x = (u32)mlb[rowoff[0] + 16 * et] | ((u32)mlb[rowoff[1] + 16 * et] << 16); t.y = (u32)mlb[rowoff[2] + 16 * et] | ((u32)mlb[rowoff[3] + 16 * et] << 16);
                    t.z = (u32)mlb[rowoff[4] + 16 * et] | ((u32)mlb[rowoff[5] + 16 * et] << 16); t.w = (u32)mlb[rowoff[6] + 16 * et] | ((u32)mlb[rowoff[7] + 16 * et] << 16); vf[et][sb] = __builtin_bit_cast(bf16x8, t); } }
            float eg[4][4];
#pragma unroll
            for (int s4 = 0; s4 < 4; ++s4)
#pragma unroll
                for (int j = 0; j < 4; ++j) { const int sp = 16 * s4 + 4 * fq + j; eg[s4][j] = wsm[64 + sp] - wsm[sp]; }
#pragma unroll
            for (int lt = 0; lt < 4; ++lt) {
                const int lp = 16 * lt + fr;
                const bf16x8 q0 = qf[lt][0], q1 = qf[lt][1];
                const float bl = wsm[lp], inter = bl + mprev;
                f32x4 st[4]; float mt = -1e30f;
#pragma unroll
                for (int s4 = 0; s4 < 4; ++s4) {
                    if (s4 <= lt) { f32x4 a = {0.f, 0.f, 0.f, 0.f}; a = mfma16(kf[s4][0], q0, a); a = mfma16(kf[s4][1], q1, a); st[s4] = a;
#pragma unroll
                        for (int j = 0; j < 4; ++j) { float d = bl + eg[s4][j]; if (s4 == lt) d = (4 * fq + j <= fr) ? d : -1e30f; mt = fmaxf(mt, d); } }
                    else st[s4] = (f32x4){0.f, 0.f, 0.f, 0.f}; }
                mt = fmaxf(mt, shfl_xor_f(mt, 16)); mt = fmaxf(mt, shfl_xor_f(mt, 32)); mt = fmaxf(mt, inter);
                float dsum = 0.f;
#pragma unroll
                for (int s4 = 0; s4 < 4; ++s4)
#pragma unroll
                    for (int j = 0; j < 4; ++j) { float d = bl + eg[s4][j]; if (s4 == lt) d = (4 * fq + j <= fr) ? d : -1e30f;
                        const float p = (s4 <= lt) ? st[s4][j] * 0.125f * fexp(d - mt) : 0.f; st[s4][j] = p; dsum += p; }
                dsum += shfl_xor_f(dsum, 16); dsum += shfl_xor_f(dsum, 32);
                const float ainter = fexp(inter - mt);
                const bf16x8 p0 = pack8(st[0], st[1]), p1 = pack8(st[2], st[3]);
                f32x4 qn = {0.f, 0.f, 0.f, 0.f}; qn = mfma16(nf[0], q0, qn); qn = mfma16(nf[1], q1, qn);
                const float qnl = shfl_f(qn[0], fr);
                const float den = ainter * qnl + dsum, rden = frcp(fmaxf(fabsf(den), fexp(-mt)));
#pragma unroll
                for (int et = 0; et < 4; ++et) { f32x4 a = {0.f, 0.f, 0.f, 0.f}; const bf16* cp = cml + it * 4096 + (16 * et + fr) * 64 + 8 * fq;
                    a = mfma16(ldfrag(cp), q0, a); a = mfma16(ldfrag(cp + 32), q1, a); a = a * ainter;
                    a = mfma16(vf[et][0], p0, a); if (lt >= 2) a = mfma16(vf[et][1], p1, a);
                    const int l = dir ? 63 - lp : lp;
#pragma unroll
                    for (int j = 0; j < 4; ++j) { LAS float* hp = hbuf + l * 65 + 16 * et + 4 * fq + j; if (dir == 0) *hp = a[j] * rden; else *hp += a[j] * rden; } }
            }
            wave_sync();
        }
        { const size_t tok = tok0 + lane; float ss = 0.f;
#pragma unroll 16
            for (int e = 0; e < 64; ++e) { const float v = hbuf[lane * 65 + e]; ss += v * v; }
            const float r = frsq(ss * (1.f / 64.f) + EPS);
            const bf16* op = mlb + tok * MLB_LD + 768 + h * 64; bf16* yp = xy + tok * D + 384 + h * 64;
#pragma unroll 2
            for (int e8 = 0; e8 < 8; ++e8) { const u32x4 ow = ld16(op + 8 * e8); const u32 owv[4] = {ow.x, ow.y, ow.z, ow.w}; u32 res[4];
#pragma unroll
                for (int j = 0; j < 4; ++j) { const int e = 8 * e8 + 2 * j; const float y0 = hbuf[lane * 65 + e] * r * norm_w[h * 64 + e] * sigmoidf_(bflo(owv[j])), y1 = hbuf[lane * 65 + e + 1] * r * norm_w[h * 64 + e + 1] * sigmoidf_(bfhi(owv[j])); res[j] = pk2(y0, y1); }
                u32x4 o; o.x = res[0]; o.y = res[1]; o.z = res[2]; o.w = res[3]; *(u32x4*)(yp + 8 * e8) = o; }
            wave_sync(); }
    }
}
static_assert((NC & (NC - 1)) == 0, "NC power of two");
DEV size_t gd_blk(int b, int h, int chunk) { const int bh = b * 6 + h; return (size_t)bh * NC + ((chunk + 11 * bh) & (NC - 1)); }
DEV size_t gd_slot(int b, int h, int dir, int n) { const int c = (b * 6 + h) * 2 + dir; return (size_t)c * NC + ((n + 11 * c) & (NC - 1)); }
DEV void phase_gd_conv(const bf16* __restrict__ gdb, const float* __restrict__ conv_w  , bf16* __restrict__ xy  , bf16* __restrict__ kn, bf16* __restrict__ knt, bf16* __restrict__ vnt,
                       LAS bf16* tl_  , int gw, int NGW, int lane) {
    const int tl = lane >> 3, cg = lane & 7;
    for (int it = gw; it < BATCH * NC * 18; it += NGW) {
        const int sl = it % 18, bc = it / 18, chunk = bc % NC, b = bc / NC, which = sl / 6, h = sl % 6;
        const int ch = which * 384 + h * 64 + cg * 8;
        f32x4 w0[5], w1[5];
#pragma unroll
        for (int dj = 0; dj < 5; ++dj) { w0[dj] = *(const f32x4*)(conv_w + dj * 1152 + ch); w1[dj] = *(const f32x4*)(conv_w + dj * 1152 + ch + 4); }
#pragma unroll 2
        for (int tg = 0; tg < 8; ++tg) {
            const int l = tg * 8 + tl, s = chunk * 64 + l; const size_t tok = (size_t)b * SEQ + s;
            float acc[8];
#pragma unroll
            for (int j = 0; j < 8; ++j) acc[j] = 0.f;
            u32x4 xt[5];
#pragma unroll
            for (int dj = 0; dj < 5; ++dj) { int ss = s + dj - 2; ss = ss < 0 ? 0 : (ss > SEQ - 1 ? SEQ - 1 : ss); xt[dj] = ld16(gdb + ((size_t)b * SEQ + ss) * GDB_LD + ch); }
#pragma unroll
            for (int dj = 0; dj < 5; ++dj) { const int ss = s + dj - 2; const bool ok = (ss >= 0) && (ss < SEQ);
                const u32 xw[4] = {ok ? xt[dj].x : 0u, ok ? xt[dj].y : 0u, ok ? xt[dj].z : 0u, ok ? xt[dj].w : 0u};
                acc[0] += w0[dj][0] * bflo(xw[0]); acc[1] += w0[dj][1] * bfhi(xw[0]); acc[2] += w0[dj][2] * bflo(xw[1]); acc[3] += w0[dj][3] * bfhi(xw[1]);
                acc[4] += w1[dj][0] * bflo(xw[2]); acc[5] += w1[dj][1] * bfhi(xw[2]); acc[6] += w1[dj][2] * bflo(xw[3]); acc[7] += w1[dj][3] * bfhi(xw[3]); }
            float ss2 = 0.f;
#pragma unroll
            for (int j = 0; j < 8; ++j) { acc[j] = acc[j] * sigmoidf_(acc[j]); ss2 += acc[j] * acc[j]; }
            ss2 += shfl_xor_f(ss2, 1); ss2 += shfl_xor_f(ss2, 2); ss2 += shfl_xor_f(ss2, 4);
            if (which < 2) { const float r = frsq(ss2 + EPS);
#pragma unroll
                for (int j = 0; j < 8; ++j) acc[j] *= r; }
            u32x4 o; o.x = pk2(acc[0], acc[1]); o.y = pk2(acc[2], acc[3]); o.z = pk2(acc[4], acc[5]); o.w = pk2(acc[6], acc[7]);
            if (which == 0) *(u32x4*)(xy + tok * D + 640 + h * 64 + cg * 8) = o;
            else { if (which == 1) *(u32x4*)(kn + tok * 384 + h * 64 + cg * 8) = o;
#pragma unroll
                for (int j = 0; j < 8; ++j) tl_[(cg * 8 + j) * 72 + l] = (bf16)f2bf(acc[j]); }
        }
        if (which != 0) { wave_sync();
            bf16* dst = (which == 1 ? knt : vnt) + gd_blk(b, h, chunk) * 4096;
#pragma unroll
            for (int i = 0; i < 8; ++i) { const int u = lane + 64 * i, row = u >> 3, c8 = u & 7;
                *(u32x4*)(dst + row * 64 + c8 * 8) = *(const LAS u32x4*)(tl_ + row * 72 + c8 * 8); }
            wave_sync(); }
    }
}
DEV int gd_item(int b, int h, int dir, int n) { return ((b * 6 + h) * 2 + dir) * NC + n; }
DEV u32x2 ldrow4_raw(const bf16* row, int p0, int dir) { return ld8(row + (dir ? 60 - p0 : p0)); }
DEV u32x2 fixrow4(u32x2 v, int dir) { const u32x2 r = rev4(v); u32x2 o; o.x = dir ? r.x : v.x; o.y = dir ? r.y : v.y; return o; }
DEV u32x2 ldrow4(const bf16* row, int p0, int dir) { const u32x2 v = ld8(row + (dir ? 60 - p0 : p0)); const u32x2 r = rev4(v); u32x2 o; o.x = dir ? r.x : v.x; o.y = dir ? r.y : v.y; return o; }
DEV void phase_gd_prep(const bf16* xy  , const bf16* kn, const bf16* knt, const bf16* vnt, const float* gates, const float* a_log, const float* dt_bias,
                       bf16* gdb  , bf16* wf, bf16* attf, float* gst, LAS float* Al  , LAS float* wsm, int gw, int NGW, int lane0) {
    for (int it = gw; it < NITEM_GD; it += NGW) {
        int ln_ = lane0;
#ifndef EMU
        asm volatile("" : "+v"(ln_));
#endif
        const int lane = ln_, fr = lane & 15, fq = lane >> 4;
        const int dir = it & 1, chunk = (it >> 1) % NC, bh = it / (2 * NC), h = bh % 6, b = bh / 6, n = dir ? NC - 1 - chunk : chunk;
        const size_t tok0 = (size_t)b * SEQ + chunk * 64; const size_t blk = gd_blk(b, h, chunk) * 4096; const size_t slot = gd_slot(b, h, dir, n);
        { const size_t tok = tok0 + (dir ? 63 - lane : lane);
          const float alpha = gates[tok * GATES_LD + 28 + dir * 6 + h], bpre = gates[tok * GATES_LD + 16 + dir * 6 + h];
          const float g = -expf(a_log[dir * 6 + h]) * softplusf_(alpha + dt_bias[dir * 6 + h]), beta = sigmoidf_(bpre);
          const float gc = wave_incl_scan(g, lane), gl = lane63_f(gc);
          wave_sync(); wsm[lane] = gc; wsm[64 + lane] = beta; wsm[128 + lane] = beta * expf(gc); wave_sync();
          float* gs = gst + slot * 192; gs[lane] = 0.125f * expf(gc); gs[64 + lane] = expf(gl - gc); if (lane == 0) gs[128] = expf(gl); }
        bf16x8 kr[4][2];
        bf16* attp = attf + slot * 4096;
        bf16x8 qn0, qn1, kn0, kn1;
        { const int lp0 = fr; const bf16* qrow = xy + (tok0 + (dir ? 63 - lp0 : lp0)) * D + 640 + h * 64 + 8 * fq; qn0 = ldfrag(qrow); qn1 = ldfrag(qrow + 32);
          const bf16* krow = kn + (tok0 + (dir ? 63 - lp0 : lp0)) * 384 + h * 64 + 8 * fq; kn0 = ldfrag(krow); kn1 = ldfrag(krow + 32); }
#define GD_GROUP(LT) { const int lp = 16 * (LT) + fr; const float gcl = wsm[lp], bel = wsm[64 + lp]; \
            const bf16x8 q0 = qn0, q1 = qn1, kl0 = kn0, kl1 = kn1; kr[(LT)][0] = kl0; kr[(LT)][1] = kl1; \
            if ((LT) < 3) { const int lpn = 16 * ((LT) + 1) + fr; const bf16* qrow = xy + (tok0 + (dir ? 63 - lpn : lpn)) * D + 640 + h * 64 + 8 * fq; qn0 = ldfrag(qrow); qn1 = ldfrag(qrow + 32); \
              const bf16* krow = kn + (tok0 + (dir ? 63 - lpn : lpn)) * 384 + h * 64 + 8 * fq; kn0 = ldfrag(krow); kn1 = ldfrag(krow + 32); } \
            f32x4 at[4]; \
            _Pragma("unroll") for (int s4 = 0; s4 < 4; ++s4) { \
                if (s4 <= (LT)) { f32x4 x = {0.f, 0.f, 0.f, 0.f}; x = mfma16(kr[s4][0], kl0, x); x = mfma16(kr[s4][1], kl1, x); \
                    f32x4 y = {0.f, 0.f, 0.f, 0.f}; y = mfma16(kr[s4][0], q0, y); y = mfma16(kr[s4][1], q1, y); f32x4 av; \
                    const f32x4 gcs_ = *(const LAS f32x4*)(wsm + 16 * s4 + 4 * fq); \
                    _Pragma("unroll") for (int j = 0; j < 4; ++j) { float dec = fexp(gcl - gcs_[j]); float da = dec; \
                        if (s4 == (LT)) { dec = (4 * fq + j <= fr) ? dec : 0.f; da = (4 * fq + j < fr) ? da : 0.f; } \
                        av[j] = bel * x[j] * da; y[j] = y[j] * 0.125f * dec; } \
                    *(LAS f32x4*)(Al + lp * 64 + 16 * s4 + 4 * fq) = av; at[s4] = y; } \
                } \
            { u32 z0_ = 0u; LAUNDER_V(z0_); u32x4 f0 = {z0_, z0_, z0_, z0_}, f1 = f0;                  \
              f0.x = pk2(at[0][0], at[0][1]); f0.y = pk2(at[0][2], at[0][3]); if ((LT) >= 1) { f0.z = pk2(at[1][0], at[1][1]); f0.w = pk2(at[1][2], at[1][3]); } \
              if ((LT) >= 2) { f1.x = pk2(at[2][0], at[2][1]); f1.y = pk2(at[2][2], at[2][3]); } if ((LT) >= 3) { f1.z = pk2(at[3][0], at[3][1]); f1.w = pk2(at[3][2], at[3][3]); } \
              *(u32x4*)(attp + (((LT) * 2 + 0) * 64 + lane) * 8) = f0; *(u32x4*)(attp + (((LT) * 2 + 1) * 64 + lane) * 8) = f1; } SCHED_FENCE(); }
        GD_GROUP(0) GD_GROUP(1) GD_GROUP(2) GD_GROUP(3)
#undef GD_GROUP
        u32x4 vl[8];
#pragma unroll
        for (int i = 0; i < 8; ++i) vl[i] = ld16(vnt + blk + (size_t)(lane + 64 * i) * 8);
        wave_sync();
        float t[64];
#pragma unroll
        for (int i = 0; i < 64; ++i) {
            float a[4] = {(i == lane) ? 1.f : 0.f, 0.f, 0.f, 0.f};
#pragma unroll
            for (int hb_ = 0; hb_ < (i + 31) / 32; ++hb_) { f32x4 row[8]; const int nch = (i - 32 * hb_ + 3) / 4 > 8 ? 8 : (i - 32 * hb_ + 3) / 4;
#pragma unroll
                for (int j4 = 0; j4 < nch; ++j4) row[j4] = *(const LAS f32x4*)(Al + i * 64 + 32 * hb_ + 4 * j4);
                SCHED_FENCE();
#pragma unroll
                for (int j4 = 0; j4 < nch; ++j4)
#pragma unroll
                    for (int j = 0; j < 4; ++j) if (32 * hb_ + 4 * j4 + j < i) a[j] -= row[j4][j] * t[32 * hb_ + 4 * j4 + j];
                SCHED_FENCE(); }
            t[i] = (a[0] + a[1]) + (a[2] + a[3]); }
        wave_sync();
        LAS bf16* Tl = (LAS bf16*)Al;
#pragma unroll
        for (int i = 0; i < 64; ++i) Tl[i * 64 + lane] = (bf16)f2bf(t[i]);
        wave_sync();
        bf16x8 tf[4][2];
#pragma unroll
        for (int lt = 0; lt < 4; ++lt)
#pragma unroll
            for (int sb = 0; sb < 2; ++sb) { const LAS bf16* tr = Tl + (16 * lt + fr) * 64 + 32 * sb + 4 * fq; tf[lt][sb] = frag2(*(const LAS u32x2*)tr, *(const LAS u32x2*)(tr + 16)); }
        LAS unsigned char* Bl = (LAS unsigned char*)Al + 8192;
#pragma unroll
        for (int i = 0; i < 8; ++i) { const int u = lane + 64 * i, r = u >> 3; *(LAS u32x4*)(Bl + r * 128 + (((u & 7) ^ (r & 7)) << 4)) = vl[i]; }
        u32x4 kl[8];
#pragma unroll
        for (int i = 0; i < 8; ++i) kl[i] = ld16(knt + blk + (size_t)(lane + 64 * i) * 8);
        wave_sync();
#define BL_ROW4(r, p0) (*(const LAS u32x2*)(Bl + (r) * 128 + (((((dir ? 60 - (p0) : (p0)) >> 3)) ^ ((r) & 7)) << 4) + (((dir ? 60 - (p0) : (p0)) & 7) << 1)))
        const int ucol = dir ? 384 : 0;
#pragma unroll
        for (int et = 0; et < 4; ++et) { bf16x8 vb[2];
#pragma unroll
            for (int sb = 0; sb < 2; ++sb) { const int s0 = 32 * sb + 4 * fq, s1 = s0 + 16, re = 16 * et + fr; const u32x2 a = fixrow4(BL_ROW4(re, s0), dir), c = fixrow4(BL_ROW4(re, s1), dir); u32x4 w;
                w.x = pk2(bflo(a.x) * wsm[64 + s0], bfhi(a.x) * wsm[64 + s0 + 1]); w.y = pk2(bflo(a.y) * wsm[64 + s0 + 2], bfhi(a.y) * wsm[64 + s0 + 3]);
                w.z = pk2(bflo(c.x) * wsm[64 + s1], bfhi(c.x) * wsm[64 + s1 + 1]); w.w = pk2(bflo(c.y) * wsm[64 + s1 + 2], bfhi(c.y) * wsm[64 + s1 + 3]); vb[sb] = __builtin_bit_cast(bf16x8, w); }
#pragma unroll
            for (int lt = 0; lt < 4; ++lt) { f32x4 u = {0.f, 0.f, 0.f, 0.f}; u = mfma16(tf[lt][0], vb[0], u); u = mfma16(tf[lt][1], vb[1], u);
                u32x2 w; w.x = pk2(u[0], u[1]); w.y = pk2(u[2], u[3]);
                *(u32x2*)(gdb + (tok0 + 16 * et + fr) * GDB_LD + ucol + h * 64 + 16 * lt + 4 * fq) = w; } }
        bf16* wp = wf + slot * 4096;
        wave_sync();
#pragma unroll
        for (int i = 0; i < 8; ++i) { const int u = lane + 64 * i, r = u >> 3; *(LAS u32x4*)(Bl + r * 128 + (((u & 7) ^ (r & 7)) << 4)) = kl[i]; }
        wave_sync();
#pragma unroll
        for (int db = 0; db < 2; ++db) { f32x4 wa[2][4];
#pragma unroll
            for (int d2 = 0; d2 < 2; ++d2) { const int dt = 2 * db + d2; bf16x8 kb[2];
#pragma unroll
                for (int sb = 0; sb < 2; ++sb) { const int s0 = 32 * sb + 4 * fq, s1 = s0 + 16, rd = 16 * dt + fr; const u32x2 a = fixrow4(BL_ROW4(rd, s0), dir), c = fixrow4(BL_ROW4(rd, s1), dir); u32x4 w;
                    w.x = pk2(bflo(a.x) * wsm[128 + s0], bfhi(a.x) * wsm[128 + s0 + 1]); w.y = pk2(bflo(a.y) * wsm[128 + s0 + 2], bfhi(a.y) * wsm[128 + s0 + 3]);
                    w.z = pk2(bflo(c.x) * wsm[128 + s1], bfhi(c.x) * wsm[128 + s1 + 1]); w.w = pk2(bflo(c.y) * wsm[128 + s1 + 2], bfhi(c.y) * wsm[128 + s1 + 3]); kb[sb] = __builtin_bit_cast(bf16x8, w); }
#pragma unroll
                for (int lt = 0; lt < 4; ++lt) { f32x4 x = {0.f, 0.f, 0.f, 0.f}; x = mfma16(kb[0], tf[lt][0], x); x = mfma16(kb[1], tf[lt][1], x); wa[d2][lt] = -x; } }
#pragma unroll
            for (int lt = 0; lt < 4; ++lt) *(u32x4*)(wp + ((lt * 2 + db) * 64 + lane) * 8) = __builtin_bit_cast(u32x4, pack8(wa[0][lt], wa[1][lt])); }
        wave_sync();
#undef BL_ROW4
    }
}
constexpr int RS_P = 144;
constexpr int RS_W = 0, RS_ATT = 8192, RS_U = 16384, RS_Q = RS_U + 64 * RS_P, RS_KT = RS_Q + 64 * RS_P, RS_ST = RS_KT + 64 * RS_P, RS_BYTES = RS_ST + 1024;
static_assert(2 * RS_BYTES <= RING_BYTES, "recurrence stages");
struct GdLoad { u32x4 w[2], a[2], u[2], q[2], k[2], s; };
DEV void gd_issue(GdLoad& L, const bf16* xy, const bf16* knt, const bf16* gdb, const bf16* wf, const bf16* attf, const float* gst, int b, int h, int dir, int n, int lt_) {
    const int chunk = dir ? NC - 1 - n : n; const size_t it = gd_slot(b, h, dir, n); const size_t tok0 = (size_t)b * SEQ + chunk * 64; const size_t blk = gd_blk(b, h, chunk) * 4096;
#pragma unroll
    for (int i = 0; i < 2; ++i) { const int u = lt_ + 256 * i;
        L.w[i] = ld16(wf + it * 4096 + u * 8); L.a[i] = ld16(attf + it * 4096 + u * 8);
        const int row = u >> 3, c8 = u & 7;
        L.u[i] = ld16(gdb + (tok0 + row) * GDB_LD + (dir ? 384 : 0) + h * 64 + c8 * 8);
        L.q[i] = ld16(xy + (tok0 + (dir ? 63 - row : row)) * D + 640 + h * 64 + c8 * 8);
        L.k[i] = ld16(knt + blk + (size_t)row * 64 + (dir ? 7 - c8 : c8) * 8); }
    L.s = ld16(gst + it * 192 + (lt_ < 48 ? lt_ : 47) * 4);
}
DEV void gd_commit(const GdLoad& L, LAS unsigned char* st, int lt_, int dir) {
#pragma unroll
    for (int i = 0; i < 2; ++i) { const int u = lt_ + 256 * i;
        *(LAS u32x4*)(st + RS_W + u * 16) = L.w[i]; *(LAS u32x4*)(st + RS_ATT + u * 16) = L.a[i]; const int po = (u >> 3) * RS_P + (u & 7) * 16; *(LAS u32x4*)(st + RS_U + po) = L.u[i];
        *(LAS u32x4*)(st + RS_Q + po) = L.q[i]; const u32x4 kr_ = rev8(L.k[i]); u32x4 kk; kk.x = dir ? kr_.x : L.k[i].x; kk.y = dir ? kr_.y : L.k[i].y; kk.z = dir ? kr_.z : L.k[i].z; kk.w = dir ? kr_.w : L.k[i].w; *(LAS u32x4*)(st + RS_KT + po) = kk; }
    if (lt_ < 48) *(LAS u32x4*)(st + RS_ST + lt_ * 16) = L.s;
}
DEV void gd_step(f32x4 (&S)[4], const LAS unsigned char* st, bf16* gdb, bf16* obw, int b, int h, int dir, int n, int es, int lane) {
    const int fr = lane & 15, fq = lane >> 4;
    const int chunk = dir ? NC - 1 - n : n; const size_t tok0 = (size_t)b * SEQ + chunk * 64;
    const LAS float* stf = (const LAS float*)(st + RS_ST);
    bf16x8 wfr[4][2], afr[4][2], qfr[4][2], kfr[4][2]; u32x2 uw[4]; f32x4 eq[4], ek[4];
#pragma unroll
    for (int lt = 0; lt < 4; ++lt) { uw[lt] = *(const LAS u32x2*)(st + RS_U + (16 * es + fr) * RS_P + (16 * lt + 4 * fq) * 2);
        wfr[lt][0] = *(const LAS bf16x8*)(st + RS_W + ((lt * 2 + 0) * 64 + lane) * 16); wfr[lt][1] = *(const LAS bf16x8*)(st + RS_W + ((lt * 2 + 1) * 64 + lane) * 16);
        const LAS bf16* qr = (const LAS bf16*)(st + RS_Q + (16 * lt + fr) * RS_P) + 4 * fq;
        qfr[lt][0] = frag2(*(const LAS u32x2*)qr, *(const LAS u32x2*)(qr + 16)); qfr[lt][1] = frag2(*(const LAS u32x2*)(qr + 32), *(const LAS u32x2*)(qr + 48));
        eq[lt] = *(const LAS f32x4*)(stf + 16 * lt + 4 * fq); }
    const float egl = stf[128];
#pragma unroll
    for (int lt = 0; lt < 4; ++lt) { afr[lt][0] = *(const LAS bf16x8*)(st + RS_ATT + ((lt * 2 + 0) * 64 + lane) * 16); afr[lt][1] = *(const LAS bf16x8*)(st + RS_ATT + ((lt * 2 + 1) * 64 + lane) * 16);
        ek[lt] = *(const LAS f32x4*)(stf + 64 + 16 * lt + 4 * fq); }
    SCHED_FENCE();
    const bf16x8 sb0 = pack8(S[0], S[1]), sb1 = pack8(S[2], S[3]);
    f32x4 vn[4], o[4];
#pragma unroll
    for (int lt = 0; lt < 4; ++lt) {
        f32x4 v = {bflo(uw[lt].x), bfhi(uw[lt].x), bflo(uw[lt].y), bfhi(uw[lt].y)};
        v = mfma16(wfr[lt][0], sb0, v); v = mfma16(wfr[lt][1], sb1, v); vn[lt] = v;
        f32x4 x = {0.f, 0.f, 0.f, 0.f}; x = mfma16(qfr[lt][0], sb0, x); x = mfma16(qfr[lt][1], sb1, x); o[lt] = x * eq[lt]; }
#pragma unroll
    for (int lt = 0; lt < 4; ++lt) { const LAS bf16* kr = (const LAS bf16*)(st + RS_KT + (16 * lt + fr) * RS_P) + 4 * fq;
        kfr[lt][0] = frag2(*(const LAS u32x2*)kr, *(const LAS u32x2*)(kr + 16)); kfr[lt][1] = frag2(*(const LAS u32x2*)(kr + 32), *(const LAS u32x2*)(kr + 48)); }
    const bf16x8 vb0 = pack8(vn[0], vn[1]), vb1 = pack8(vn[2], vn[3]);
#pragma unroll
    for (int lt = 0; lt < 4; ++lt) {
        f32x4 x = o[lt]; x = mfma16(afr[lt][0], vb0, x); x = mfma16(afr[lt][1], vb1, x);
        u32x2 w; w.x = pk2(x[0], x[1]); w.y = pk2(x[2], x[3]);
        if (dir == 0) *(u32x2*)(gdb + (tok0 + 16 * es + fr) * GDB_LD + 768 + h * 64 + 16 * lt + 4 * fq) = w;
        else *(u32x2*)(obw + gd_blk(b, h, chunk) * 4096 + (16 * es + fr) * 64 + 16 * lt + 4 * fq) = w;
        vn[lt] = vn[lt] * ek[lt]; }
    const bf16x8 vs0 = pack8(vn[0], vn[1]), vs1 = pack8(vn[2], vn[3]);
#pragma unroll
    for (int dt = 0; dt < 4; ++dt) { f32x4 x = S[dt] * egl; x = mfma16(kfr[dt][0], vs0, x); x = mfma16(kfr[dt][1], vs1, x); S[dt] = x; }
}
DEV void phase_gd_recur(const bf16* xy, const bf16* knt, bf16* gdb, const bf16* wf, const bf16* attf, const float* gst, bf16* obw, LAS unsigned char* lds, int bid, int G, int tid) {
    const int wave = rfl(tid >> 6), lane = tid & 63; const bool loader = wave >= 4; const int lt_ = tid - 256;
    static_assert(NC >= 4, "recurrence pipeline");
    for (int chain = bid; chain < BATCH * 6 * 2; chain += G) {
        const int dir = chain & 1, bh = chain >> 1, h = bh % 6, b = bh / 6;
        if (loader) {
            GdLoad L0, L1, L2;
            gd_issue(L0, xy, knt, gdb, wf, attf, gst, b, h, dir, 0, lt_); gd_commit(L0, lds, lt_, dir);
            gd_issue(L1, xy, knt, gdb, wf, attf, gst, b, h, dir, 1, lt_); gd_issue(L2, xy, knt, gdb, wf, attf, gst, b, h, dir, 2, lt_); gd_issue(L0, xy, knt, gdb, wf, attf, gst, b, h, dir, 3, lt_);
            lds_barrier();
#define GD_SUB(k, SET) { gd_commit(SET, lds + (((k) + 1) & 1) * RS_BYTES, lt_, dir); { const int s4_ = n + (k) + 4; gd_issue(SET, xy, knt, gdb, wf, attf, gst, b, h, dir, s4_ < NC ? s4_ : NC - 1, lt_); } lds_barrier(); }
            int n = 0;
#pragma unroll 1
            for (; n + 6 <= NC; n += 6) { GD_SUB(0, L1) GD_SUB(1, L2) GD_SUB(2, L0) GD_SUB(3, L1) GD_SUB(4, L2) GD_SUB(5, L0) }
            if constexpr (NC % 6 >= 1) GD_SUB(0, L1)
            if constexpr (NC % 6 >= 2) GD_SUB(1, L2)
            if constexpr (NC % 6 >= 3) GD_SUB(2, L0)
            if constexpr (NC % 6 >= 4) GD_SUB(3, L1)
            if constexpr (NC % 6 >= 5) GD_SUB(4, L2)
#undef GD_SUB
        } else {
            f32x4 S[4];
#pragma unroll
            for (int dt = 0; dt < 4; ++dt) S[dt] = (f32x4){0.f, 0.f, 0.f, 0.f};
            lds_barrier();
#pragma unroll 1
            for (int n = 0; n < NC; ++n) { gd_step(S, lds + (n & 1) * RS_BYTES, gdb, obw, b, h, dir, n, wave, lane); lds_barrier(); }
        }
    }
}
DEV void phase_gd_final(const bf16* __restrict__ gdb, const bf16* __restrict__ obw, const float* __restrict__ norm_w, bf16* __restrict__ xy, LAS float* hb  , int gw, int NGW, int lane) {
    const int er = lane >> 3, c8 = lane & 7;
    for (int wi = gw; wi < BATCH * NC * 6; wi += NGW) {
        const int h = wi % 6, bc = wi / 6, chunk = bc % NC, b = bc / NC; const size_t tok0 = (size_t)b * SEQ + chunk * 64, tok = tok0 + lane;
        const bf16* ob = obw + gd_blk(b, h, chunk) * 4096;
        u32x4 f[8], g[8], zv[8];
#pragma unroll
        for (int i = 0; i < 8; ++i) { const int e = er + 8 * i; f[i] = ld16(gdb + (tok0 + e) * GDB_LD + 768 + h * 64 + c8 * 8); g[i] = ld16(ob + e * 64 + (7 - c8) * 8); }
#pragma unroll
        for (int e8 = 0; e8 < 8; ++e8) zv[e8] = ld16(gdb + tok * GDB_LD + 1152 + h * 64 + 8 * e8);
#pragma unroll
        for (int i = 0; i < 8; ++i) { const int e = er + 8 * i; const u32x4 gr = rev8(g[i]); const u32 fw[4] = {f[i].x, f[i].y, f[i].z, f[i].w}, gw_[4] = {gr.x, gr.y, gr.z, gr.w};
#pragma unroll
            for (int j = 0; j < 4; ++j) { hb[(8 * c8 + 2 * j) * 65 + e] = bflo(fw[j]) + bflo(gw_[j]); hb[(8 * c8 + 2 * j + 1) * 65 + e] = bfhi(fw[j]) + bfhi(gw_[j]); } }
        wave_sync();
        float ss = 0.f;
#pragma unroll 16
        for (int e = 0; e < 64; ++e) { const float v = hb[lane * 65 + e]; ss += v * v; }
        const float r = frsq(ss * (1.f / 64.f) + EPS);
#pragma unroll
        for (int e8 = 0; e8 < 8; ++e8) { const u32 zw[4] = {zv[e8].x, zv[e8].y, zv[e8].z, zv[e8].w}; u32 res[4];
#pragma unroll
            for (int j = 0; j < 4; ++j) { const int e = 8 * e8 + 2 * j; const float z0 = bflo(zw[j]), z1 = bfhi(zw[j]);
                res[j] = pk2(hb[lane * 65 + e] * r * norm_w[h * 64 + e] * z0 * sigmoidf_(z0), hb[lane * 65 + e + 1] * r * norm_w[h * 64 + e + 1] * z1 * sigmoidf_(z1)); }
            u32x4 o; o.x = res[0]; o.y = res[1]; o.z = res[2]; o.w = res[3]; *(u32x4*)(xy + tok * D + 640 + h * 64 + 8 * e8) = o; }
        wave_sync();
    }
}
constexpr int XA_PITCH = 528;
static_assert(256 * XA_PITCH <= MISC_OFF, "cross-attention LDS image");
DEV void xa_stage(const bf16* base, size_t pitch_el, LAS unsigned char* lds, int tid) {
#pragma unroll 1
    for (int hf = 0; hf < 2; ++hf) { u32x4 r[8];
#pragma unroll
        for (int i = 0; i < 8; ++i) { const int idx = tid + 512 * (8 * hf + i); r[i] = ld16(base + (size_t)(idx >> 5) * pitch_el + (idx & 31) * 8); }
#pragma unroll
        for (int i = 0; i < 8; ++i) { const int idx = tid + 512 * (8 * hf + i); *(LAS u32x4*)(lds + (idx >> 5) * XA_PITCH + (idx & 31) * 16) = r[i]; } }
}
DEV void phase_xattn(const bf16* __restrict__ qx, const bf16* __restrict__ kx  , const bf16* __restrict__ vtx  , bf16* __restrict__ out, LAS unsigned char* lds, int bid, int G, int tid) {
    const int wave = rfl(tid >> 6), lane = tid & 63, fr = lane & 15, fq = lane >> 4;
    constexpr int NU = (T / 256) * 4;
    for (int un = bid; un < NU; un += G) {
        const int hx = un & 3, qb = un >> 2; const size_t row0 = (size_t)qb * 256 + wave * 32; const int b = (int)(((size_t)qb * 256) / SEQ);
        xa_stage(kx + (size_t)b * NMEM * D + hx * 256, D, lds, tid);
        const bf16* qrow0 = qx + (row0 + fr) * D + hx * 256 + 8 * fq; const bf16* qrow1 = qrow0 + (size_t)16 * D;
        bf16x8 qn0 = ldfrag(qrow0), qn1 = ldfrag(qrow1);
        __syncthreads();
        f32x4 sacc[16][2];
#pragma unroll
        for (int mt = 0; mt < 16; ++mt) { sacc[mt][0] = (f32x4){0.f, 0.f, 0.f, 0.f}; sacc[mt][1] = (f32x4){0.f, 0.f, 0.f, 0.f}; }
#pragma unroll 1
        for (int kb = 0; kb < 8; ++kb) { const bf16x8 q0 = qn0, q1 = qn1; if (kb < 7) { qn0 = ldfrag(qrow0 + 32 * (kb + 1)); qn1 = ldfrag(qrow1 + 32 * (kb + 1)); }
            const LAS unsigned char* kr = lds + fr * XA_PITCH + 16 * fq + 64 * kb;
#pragma unroll
            for (int mt = 0; mt < 16; ++mt) { const bf16x8 kf = *(const LAS bf16x8*)(kr + 16 * mt * XA_PITCH); sacc[mt][0] = mfma16(kf, q0, sacc[mt][0]); sacc[mt][1] = mfma16(kf, q1, sacc[mt][1]); } }
        float inv[2]; bf16x8 pf[8][2];
#pragma unroll
        for (int qt = 0; qt < 2; ++qt) { float mx = -1e30f;
#pragma unroll
            for (int mt = 0; mt < 16; ++mt)
#pragma unroll
                for (int j = 0; j < 4; ++j) mx = fmaxf(mx, sacc[mt][qt][j]);
            mx = fmaxf(mx, shfl_xor_f(mx, 16)); mx = fmaxf(mx, shfl_xor_f(mx, 32));
            float sum = 0.f;
#pragma unroll
            for (int mt = 0; mt < 16; ++mt)
#pragma unroll
                for (int j = 0; j < 4; ++j) { const float p = fexp((sacc[mt][qt][j] - mx) * 0.0625f); sacc[mt][qt][j] = p; sum += p; }
            sum += shfl_xor_f(sum, 16); sum += shfl_xor_f(sum, 32); inv[qt] = frcp(sum);
#pragma unroll
            for (int mb = 0; mb < 8; ++mb) pf[mb][qt] = pack8(sacc[2 * mb][qt], sacc[2 * mb + 1][qt]); }
        __syncthreads();
        xa_stage(vtx + (size_t)(hx * 256) * NMEMROWS + (size_t)b * NMEM, NMEMROWS, lds, tid);
        __syncthreads();
#pragma unroll 2
        for (int d16 = 0; d16 < 16; ++d16) { f32x4 o0 = {0.f, 0.f, 0.f, 0.f}, o1 = {0.f, 0.f, 0.f, 0.f}; const LAS unsigned char* vr = lds + (16 * d16 + fr) * XA_PITCH + 8 * fq;
#pragma unroll
            for (int mb = 0; mb < 8; ++mb) { const bf16x8 vf = frag2(*(const LAS u32x2*)(vr + 64 * mb), *(const LAS u32x2*)(vr + 64 * mb + 32)); o0 = mfma16(vf, pf[mb][0], o0); o1 = mfma16(vf, pf[mb][1], o1); }
            { const f32x4 x = o0 * inv[0]; u32x2 w; w.x = pk2(x[0], x[1]); w.y = pk2(x[2], x[3]); *(u32x2*)(out + (row0 + fr) * D + hx * 256 + 16 * d16 + 4 * fq) = w; }
            { const f32x4 x = o1 * inv[1]; u32x2 w; w.x = pk2(x[0], x[1]); w.y = pk2(x[2], x[3]); *(u32x2*)(out + (row0 + 16 + fr) * D + hx * 256 + 16 * d16 + 4 * fq) = w; } }
        __syncthreads();
    }
}
#ifndef MK_SPLIT
#define MK_SPLIT 0
#endif
constexpr int NPL = 14, NPHASE = 2 + DEPTH * NPL;
constexpr int NCHAIN_GD = BATCH * 6 * 2;
struct Args { const float* in[22]; float* out; unsigned char* ws; int ph_lo, ph_hi; };
__global__ void __launch_bounds__(NWAVES * 64, 2) fwd_kernel(Args args) {
#ifndef EMU
    extern __shared__ __attribute__((aligned(16))) unsigned char lds_raw[];
    LAS unsigned char* lds = (LAS unsigned char*)lds_raw;
#else
    unsigned char* lds = emu_lds();
#endif
    const int bid = blockIdx.x, G = gridDim.x, NGW = G * NWAVES;
    const int wave_s = rfl((int)threadIdx.x >> 6);
#ifndef EMU
    { const int t0 = threadIdx.x;
      for (int u = t0; u < (LDS_BYTES - MISC_OFF) / 4; u += NWAVES * 64) ((LAS unsigned*)(lds + MISC_OFF))[u] = 0u; }
    __syncthreads();
    XcdBarrier bar; bar.wv = wave_s; bar.bar = (unsigned*)(args.ws + WS_CTL) + CW_BAR; bar.x = 0; bar.st = nullptr;
    if (!MK_SPLIT) bar = xcd_barrier_post((unsigned*)(args.ws + WS_CTL) + CW_BAR, (volatile LAS unsigned*)(lds + MISC_OFF) + 8);
#define GRID_BAR() do { if (!MK_SPLIT) xcd_barrier(bar); } while (0)
#define SUB_BAR(key, n) sub_barrier((unsigned*)(args.ws + WS_CTL) + 8192 + 64 * (key), (unsigned)(n), (unsigned*)(args.ws + WS_CTL) + CW_BAR + XB_TMO, wave_s == 0 && lane_id() == 0)
#define PH_LOCALS() int z_ = 0; asm volatile("" : "+s"(z_)); int tid = wave_s * 64 + lane_id(); asm volatile("" : "+v"(tid)); \
    const int lane = tid & 63, wave = rfl(tid >> 6), gw = bid * NWAVES + wave; unsigned char* ws = args.ws + z_; float* xo = args.out + z_; unsigned char* pro = PRO_IN_OUT ? (unsigned char*)xo : ws; (void)pro; unsigned char* absb = ABS_IN_OUT ? (unsigned char*)xo : ws; (void)absb; \
    LAS float* wscr = (LAS float*)(lds + wave * WSCR_BYTES); LAS float* wsm = (LAS float*)(lds + WSM_OFF + wave * 1024); \
    bf16* XY = (bf16*)(ws + WS_XY); bf16* YB = (bf16*)xo; bf16* NAB = (bf16*)(ws + WS_NAB); bf16* MLB = (bf16*)(ws + WS_MLB); bf16* GDB = (bf16*)(ws + WS_GDB); float* GATES = (float*)(ws + WS_GATES); \
    (void)YB; (void)lane; (void)gw; (void)xo; (void)wscr; (void)wsm; (void)XY; (void)NAB; (void)MLB; (void)GDB; (void)GATES;
#define AIN(k) (args.in[(k) + z_])
#else
#define GRID_BAR() emu_grid_sync()
#define SUB_BAR(key, n) emu_sub_sync((key), (int)(n) * 512)
#define PH_LOCALS() int z_ = 0; int tid = wave_s * 64 + lane_id(); \
    const int lane = tid & 63, wave = rfl(tid >> 6), gw = bid * NWAVES + wave; unsigned char* ws = args.ws + z_; float* xo = args.out + z_; unsigned char* pro = PRO_IN_OUT ? (unsigned char*)xo : ws; (void)pro; unsigned char* absb = ABS_IN_OUT ? (unsigned char*)xo : ws; (void)absb; \
    LAS float* wscr = (LAS float*)(lds + wave * WSCR_BYTES); LAS float* wsm = (LAS float*)(lds + WSM_OFF + wave * 1024); \
    bf16* XY = (bf16*)(ws + WS_XY); bf16* YB = (bf16*)xo; bf16* NAB = (bf16*)(ws + WS_NAB); bf16* MLB = (bf16*)(ws + WS_MLB); bf16* GDB = (bf16*)(ws + WS_GDB); float* GATES = (float*)(ws + WS_GATES); \
    (void)YB; (void)lane; (void)gw; (void)xo; (void)wscr; (void)wsm; (void)XY; (void)NAB; (void)MLB; (void)GDB; (void)GATES;
#define AIN(k) (args.in[(k) + z_])
#endif
    const int lo = args.ph_lo, hi = args.ph_hi;
#define IN(k) (lo <= (k) && (k) < hi)
#define SEAM(k) do { if (IN((k) + 1)) GRID_BAR(); } while (0)
#define SEAM2(k) do { if (IN((k) + 2)) GRID_BAR(); } while (0)

    if (IN(0)) { PH_LOCALS();
        P0Args a{AIN(3), AIN(12), AIN(15), AIN(16), AIN(17), AIN(19), AIN(20), AIN(0), AIN(1), AIN(2), AIN(14), AIN(13), AIN(18)};
        phase_prologue(a, ws, pro, wscr, gw, NGW, lane);
        SEAM2(0);
    }
#define KV_GEMMS(Gv, cv) do { for (int i = 0; i < DEPTH; ++i) { \
            const bf16* memn = (const bf16*)(pro + PRO_MEMN) + (size_t)i * NMEMROWS * D; const bf16* wkv = (const bf16*)(pro + PRO_WXKV) + (size_t)i * 2048 * D; \
            pg8::Gemm g{memn, wkv, NMEMROWS, 2048, D}; \
            pg8::EpiBf16<0, 2> E{(bf16*)(ws + WS_KX) + (size_t)i * NMEMROWS * D, 256, nullptr, (bf16*)(ws + WS_VTX) + (size_t)i * NMEMROWS * D, (LAS unsigned char*)(lds + STG_OFF)}; \
            pg8::StaticOrder S; S.init(g.M, g.N, (Gv), ((cv) + (Gv) - ((8 * BATCH * i) % (Gv))) % (Gv)); S.wv = wave_s;     \
            pg8::gemm_phase<pg8::EpiBf16<0, 2>, pg8::StaticOrder, true, true>(lds, g, S, E); } } while (0)
#define ABS_GEMMS(lsel, Gv, cv) do { const int k256 = 256 + z_;     \
        _Pragma("unroll 1") for (int i = 0; i < 2; ++i) { const int l_ = (lsel); \
            if (!(i & 1)) { pg8::Gemm g{(const bf16*)(ws + WS_KX) + (size_t)l_ * NMEMROWS * D, (const bf16*)(ws + WS_WXQ) + (size_t)l_ * D * D, NMEMROWS * 4, D, k256}; \
                pg8::EpiBf16<0> E{(bf16*)(absb + ABS_MT) + (size_t)l_ * BATCH * D * D, D, nullptr, nullptr, (LAS unsigned char*)(lds + STG_OFF)}; \
                pg8::StaticOrder S; S.init(g.M, g.N, (Gv), ((cv) + (Gv) - ((16 * BATCH * i) % (Gv))) % (Gv)); S.wv = wave_s; S.bmode = 2; \
                pg8::gemm_phase<pg8::EpiBf16<0>, pg8::StaticOrder, true, true>(lds, g, S, E); } \
            else { pg8::Gemm g{(const bf16*)(ws + WS_WXO) + (size_t)l_ * D * D, (const bf16*)(ws + WS_VTX) + (size_t)l_ * NMEMROWS * D, 4 * D, BATCH * 256, k256}; \
                pg8::EpiBf16<0, 1> E{(bf16*)(absb + ABS_NT) + (size_t)l_ * BATCH * D * D, D, nullptr, nullptr, (LAS unsigned char*)(lds + STG_OFF)}; \
                pg8::StaticOrder S; S.init(g.M, g.N, (Gv), ((cv) + (Gv) - ((16 * BATCH * i) % (Gv))) % (Gv)); S.wv = wave_s; S.bmode = 3; \
                pg8::gemm_phase<pg8::EpiBf16<0, 1>, pg8::StaticOrder, true, true>(lds, g, S, E); } } } while (0)
    for (int l = 0; l < DEPTH; ++l) {
        const int pb = 2 + l * NPL;
        if (IN(pb + 0)) { PH_LOCALS();
            pg8::Gemm g{XY, (const bf16*)(ws + WS_WIN) + (size_t)l * NPROJ * D, T, NPROJ, D}; pg8::StaticOrder S; S.init(T, NPROJ, G, bid); S.wv = wave_s;
            pg8::EpiInProj E{NAB, MLB, GDB, GATES, (const float*)(ws + WS_RSS), (LAS unsigned char*)(lds + STG_OFF)};
            pg8::gemm_phase<pg8::EpiInProj, pg8::StaticOrder, true, true>(lds, g, S, E);
            SEAM(pb + 0);
        }
        if (IN(pb + 1)) { PH_LOCALS();
            phase_na2(NAB, AIN(4) + (size_t)l * 6 * 15 * 31, YB, lds, bid, G, tid);
            __syncthreads();
            phase_gd_conv(GDB, AIN(8) + (size_t)l * 5 * 1152, YB, (bf16*)(ws + WS_KN), (bf16*)(ws + WS_KNT), (bf16*)(ws + WS_VNT), (LAS bf16*)(lds + wave * 9216), gw, NGW, lane);
            __syncthreads();
            SEAM(pb + 1);
        }
        if (IN(pb + 2)) { PH_LOCALS();
            phase_ml1(MLB, GATES, AIN(5) + l * 8, AIN(6) + l * 8, (bf16*)(ws + WS_CML), (float*)(ws + WS_NML), (float*)(ws + WS_SML), wsm, gw, NGW, lane);
            phase_gd_prep(YB, (const bf16*)(ws + WS_KN), (const bf16*)(ws + WS_KNT), (const bf16*)(ws + WS_VNT), GATES, AIN(9) + l * 12, AIN(10) + l * 12,
                          GDB, (bf16*)(ws + WS_WF), (bf16*)(ws + WS_ATT), (float*)(ws + WS_GST), wscr, wsm, gw, NGW, lane);
            __syncthreads();
            SEAM(pb + 2);
        }
        if (IN(pb + 3)) { PH_LOCALS();
            phase_gd_recur(YB, (const bf16*)(ws + WS_KNT), GDB, (const bf16*)(ws + WS_WF), (const bf16*)(ws + WS_ATT), (const float*)(ws + WS_GST), (bf16*)(ws + WS_VNT), lds, bid, G, tid);
            if (G > NCHAIN_GD) { if (bid >= NCHAIN_GD) phase_ml2((bf16*)(ws + WS_CML), (float*)(ws + WS_NML), (float*)(ws + WS_SML), (bid - NCHAIN_GD) * NWAVES * 64 + tid, (G - NCHAIN_GD) * NWAVES * 64); }
            else phase_ml2((bf16*)(ws + WS_CML), (float*)(ws + WS_NML), (float*)(ws + WS_SML), bid * NWAVES * 64 + tid, G * NWAVES * 64);
            if (!MK_SPLIT && G > NCHAIN_GD && bid >= NCHAIN_GD) {
                SUB_BAR(l, G - NCHAIN_GD);
                phase_ml3(MLB, GATES, AIN(5) + l * 8, AIN(6) + l * 8, AIN(7) + l * 256, (const bf16*)(ws + WS_CML), (const float*)(ws + WS_NML), (const float*)(ws + WS_SML), YB, wscr, wsm, (bid - NCHAIN_GD) * NWAVES + wave, (G - NCHAIN_GD) * NWAVES, lane); }
            if (l == 0) { __syncthreads(); if (G > NCHAIN_GD) { if (bid >= NCHAIN_GD) KV_GEMMS(G - NCHAIN_GD, bid - NCHAIN_GD); } else KV_GEMMS(G, bid); }
            else if (!MK_SPLIT && G > NCHAIN_GD && bid >= NCHAIN_GD) { __syncthreads(); ABS_GEMMS(l, G - NCHAIN_GD, bid - NCHAIN_GD); }
            __syncthreads();
            SEAM(pb + 3);
        }
        if (IN(pb + 4)) { PH_LOCALS();
            if (MK_SPLIT || G <= NCHAIN_GD) phase_ml3(MLB, GATES, AIN(5) + l * 8, AIN(6) + l * 8, AIN(7) + l * 256, (bf16*)(ws + WS_CML), (const float*)(ws + WS_NML), (const float*)(ws + WS_SML), YB, wscr, wsm, gw, NGW, lane);
            phase_gd_final(GDB, (const bf16*)(ws + WS_VNT), AIN(11) + l * 384, YB, wscr, gw, NGW, lane);
            __syncthreads();
            if (l == 0) ABS_GEMMS(0, G, bid);
            if (l > 0 && (MK_SPLIT || G <= NCHAIN_GD)) ABS_GEMMS(l, G, bid);
            SEAM(pb + 4);
        }
        if (IN(pb + 5)) { PH_LOCALS();
            pg8::Gemm g{YB, (const bf16*)(ws + WS_WOUT) + (size_t)l * D * D, T, D, D}; pg8::StaticOrder S; S.init(T, D, G, bid); S.wv = wave_s;
            pg8::EpiResid E{XY, D, (float*)(ws + WS_RSS), (LAS unsigned char*)(lds + STG_OFF), (LAS float*)(lds + RING_BYTES)};
            pg8::gemm_phase<pg8::EpiResid, pg8::StaticOrder, true, true>(lds, g, S, E);
            SEAM2(pb + 5);
        }
        if (IN(pb + 7)) { PH_LOCALS();
            pg8::Gemm g{XY, (const bf16*)(absb + ABS_MT) + (size_t)l * BATCH * D * D, T, D, D}; pg8::StaticOrder S; S.init(T, D, G, bid); S.wv = wave_s; S.bmode = 1; S.bdiv = SEQ / 256;
            pg8::EpiSoftmax E{YB, (const float*)(ws + WS_RSS), (LAS float*)(lds + RING_BYTES), (LAS unsigned char*)(lds + STG_OFF)};
            pg8::gemm_phase<pg8::EpiSoftmax, pg8::StaticOrder, true, true>(lds, g, S, E);
            SEAM2(pb + 7);
        }
        if (IN(pb + 9)) { PH_LOCALS();
            pg8::Gemm g{YB, (const bf16*)(absb + ABS_NT) + (size_t)l * BATCH * D * D, T, D, D}; pg8::StaticOrder S; S.init(T, D, G, bid); S.wv = wave_s; S.bmode = 1; S.bdiv = SEQ / 256;
            pg8::EpiResid E{XY, D, (float*)(ws + WS_RSS), (LAS unsigned char*)(lds + STG_OFF), (LAS float*)(lds + RING_BYTES)};
            pg8::gemm_phase<pg8::EpiResid, pg8::StaticOrder, true, true>(lds, g, S, E);
            SEAM2(pb + 9);
        }
        if (IN(pb + 11)) { PH_LOCALS();
            pg8::Gemm g{XY, (const bf16*)(ws + WS_W1) + (size_t)l * FF * D, T, FF, D}; pg8::StaticOrder S; S.init(T, FF, G, bid); S.wv = wave_s;
            pg8::EpiBf16<1> E{(bf16*)(ws + WS_H), FF, (const float*)(ws + WS_RSS), nullptr, (LAS unsigned char*)(lds + STG_OFF)};
            pg8::gemm_phase<pg8::EpiBf16<1>, pg8::StaticOrder, true, true>(lds, g, S, E);
            SEAM(pb + 11);
        }
        if (IN(pb + 12)) { PH_LOCALS();
            pg8::Gemm g{(const bf16*)(ws + WS_H), (const bf16*)(ws + WS_W2) + (size_t)l * D * FF, T, D, FF}; pg8::StaticOrder S; S.init(T, D, G, bid); S.wv = wave_s;
            pg8::EpiResid E{XY, D, (float*)(ws + WS_RSS), (LAS unsigned char*)(lds + STG_OFF), (LAS float*)(lds + RING_BYTES)};
            pg8::gemm_phase<pg8::EpiResid, pg8::StaticOrder, true, true>(lds, g, S, E);
            if (l + 1 == DEPTH) SEAM(pb + 12); else SEAM2(pb + 12);
        }
        if (IN(pb + 13) && l + 1 == DEPTH) { PH_LOCALS();
            for (int m = 2 * gw; m < T; m += 2 * NGW) {
                u32x2 t[2][4];
#pragma unroll
                for (int r = 0; r < 2; ++r) { const u32x2* xr = (const u32x2*)(XY + (size_t)(m + r) * D) + lane;
#pragma unroll
                    for (int j = 0; j < 4; ++j) t[r][j] = xr[64 * j]; }
#pragma unroll
                for (int r = 0; r < 2; ++r) { f32x4 v[4]; float s = 0.f; const f32x4* wr = (const f32x4*)AIN(21) + lane;
#pragma unroll
                    for (int j = 0; j < 4; ++j) { v[j] = (f32x4){bflo(t[r][j].x), bfhi(t[r][j].x), bflo(t[r][j].y), bfhi(t[r][j].y)}; s += (v[j][0] * v[j][0] + v[j][1] * v[j][1]) + (v[j][2] * v[j][2] + v[j][3] * v[j][3]); }
                    const float rstd = 1.f / sqrtf(wave_sum(s) * (1.f / D) + EPS); f32x4* o = (f32x4*)(xo + (size_t)(m + r) * D) + lane;
#pragma unroll
                    for (int j = 0; j < 4; ++j) o[64 * j] = v[j] * rstd * wr[64 * j]; } }
        }
    }
#undef IN
#undef SEAM
}

#ifndef EMU
extern "C" void kernel_launch(void* const* d_in, const int* in_sizes, int n_in, void* d_out, int out_size, void* d_ws, size_t ws_size, hipStream_t stream) {
    static int grid = 0;
    if (grid == 0) {
        if (n_in != 22 || in_sizes[0] != T * D || out_size != T * D || ws_size < WS_END) { fprintf(stderr, "kernel_launch: shape/workspace mismatch (n_in %d, in0 %d, out %d, ws %zu, need %zu)\n", n_in, n_in > 0 ? in_sizes[0] : -1, out_size, ws_size, (size_t)WS_END); grid = -1; return; }
        int dev = 0, cus = 0, per_cu = 0;
        if (hipGetDevice(&dev) != hipSuccess || hipDeviceGetAttribute(&cus, hipDeviceAttributeMultiprocessorCount, dev) != hipSuccess) { grid = -1; return; }
        if (hipFuncSetAttribute((const void*)fwd_kernel, hipFuncAttributeMaxDynamicSharedMemorySize, LDS_BYTES) != hipSuccess) { fprintf(stderr, "kernel_launch: hipFuncSetAttribute failed\n"); grid = -1; return; }
        if (hipOccupancyMaxActiveBlocksPerMultiprocessor(&per_cu, (const void*)fwd_kernel, NWAVES * 64, LDS_BYTES) != hipSuccess || per_cu < 1) { fprintf(stderr, "kernel_launch: occupancy query reports %d\n", per_cu); }
        (void)hipGetLastError();
        grid = cus;
    }
    if (grid < 0) return;
    if (hipMemsetAsync((char*)d_ws + WS_CTL, 0, CTL_ZERO_BYTES, stream) != hipSuccess) return;
    Args a{};
    for (int i = 0; i < 22; ++i) a.in[i] = (const float*)d_in[i];
    a.out = (float*)d_out; a.ws = (unsigned char*)d_ws;
    if (MK_SPLIT) { for (int p = 0; p < NPHASE; ++p) { a.ph_lo = p; a.ph_hi = p + 1; hipLaunchKernelGGL(fwd_kernel, dim3(grid), dim3(NWAVES * 64), LDS_BYTES, stream, a); } }
    else { a.ph_lo = 0; a.ph_hi = NPHASE; hipLaunchKernelGGL(fwd_kernel, dim3(grid), dim3(NWAVES * 64), LDS_BYTES, stream, a); }
}
#endif
```

```cpp
#ifndef EMU
#include <hip/hip_runtime.h>
#include <cstdio>
#include <cstdint>
#define DEV __device__ __forceinline__
#define LAS __attribute__((address_space(3)))
#define GAS __attribute__((address_space(1)))
#else
#include "emu.h"
#define DEV inline
#define LAS
#define GAS
#endif

#ifndef CFG_BATCH
#define CFG_BATCH 8
#endif
#ifndef CFG_SEQ
#define CFG_SEQ 8192
#endif
constexpr int BATCH = CFG_BATCH, SEQ = CFG_SEQ, D = 1024, DEPTH = 2, NMEM = 256, FF = 4096;
constexpr int T = BATCH * SEQ;
constexpr int NC = SEQ / 64;
constexpr int GROWS = SEQ / 64;
constexpr int NMEMROWS = BATCH * NMEM;
constexpr int NPROJ = 3840;
constexpr int NAB_LD = 1152, MLB_LD = 1024, GDB_LD = 1536, GATES_LD = 64;
constexpr int NITEM_ML = BATCH * 4 * 2 * NC;
constexpr int NITEM_GD = BATCH * 6 * 2 * NC;
constexpr float EPS = 1e-6f;
constexpr int NWAVES = 8;

typedef unsigned short bf16;
typedef unsigned int u32;
typedef unsigned long long u64;
typedef short bf16x8 __attribute__((ext_vector_type(8)));
typedef float f32x4 __attribute__((ext_vector_type(4)));
typedef unsigned u32x4 __attribute__((ext_vector_type(4)));
typedef unsigned u32x2 __attribute__((ext_vector_type(2)));

constexpr size_t MiB = 1u << 20;
constexpr size_t al256(size_t x) { return (x + 255) & ~(size_t)255; }
constexpr size_t WS_CTL = 0, CTL_ZERO_BYTES = 1 * MiB;
constexpr size_t WS_WIN = 1 * MiB;
constexpr size_t WS_WOUT = WS_WIN + (size_t)DEPTH * NPROJ * D * 2;
constexpr size_t WS_WXQ = WS_WOUT + (size_t)DEPTH * D * D * 2;
constexpr size_t WS_WXO = WS_WXQ + (size_t)DEPTH * D * D * 2;
constexpr size_t WS_W1 = WS_WXO + (size_t)DEPTH * D * D * 2;
constexpr size_t WS_W2 = WS_W1 + (size_t)DEPTH * FF * D * 2;
constexpr size_t WS_KX = WS_W2 + (size_t)DEPTH * FF * D * 2;
constexpr size_t WS_VTX = WS_KX + (size_t)DEPTH * NMEMROWS * D * 2;
constexpr size_t WS_XY = al256(WS_VTX + (size_t)DEPTH * NMEMROWS * D * 2);
constexpr size_t WS_NAB = WS_XY + (size_t)T * D * 2;
constexpr size_t WS_MLB = WS_NAB + (size_t)T * NAB_LD * 2;
constexpr size_t WS_GDB = WS_MLB + (size_t)T * MLB_LD * 2;
constexpr size_t WS_GATES = WS_GDB + (size_t)T * GDB_LD * 2;
constexpr size_t WS_FREE = WS_GATES + (size_t)T * GATES_LD * 4;
constexpr size_t WS_KN = WS_FREE;
constexpr size_t WS_KNT = WS_KN + (size_t)T * 384 * 2;
constexpr size_t WS_VNT = WS_KNT + (size_t)T * 384 * 2;
constexpr size_t WS_WF = WS_VNT + (size_t)T * 384 * 2;
constexpr size_t WS_ATT = WS_WF + (size_t)NITEM_GD * 8192;
constexpr size_t WS_RSS = WS_ATT + (size_t)NITEM_GD * 8192;
constexpr size_t WS_END0 = WS_RSS + (size_t)T * 64;
constexpr size_t WS_CML = WS_NAB;
constexpr size_t WS_NML = WS_CML + (size_t)NITEM_ML * 8192;
constexpr size_t WS_SML = WS_NML + (size_t)NITEM_ML * 256;
constexpr size_t WS_GST = WS_SML + (size_t)NITEM_ML * 16;
static_assert(WS_GST + (size_t)NITEM_GD * 768 <= WS_MLB, "NAB overlays");
constexpr size_t PRO_BYTES = (size_t)DEPTH * 2048 * D * 2 + (size_t)DEPTH * NMEMROWS * D * 2;
constexpr bool PRO_IN_OUT = (size_t)T * D * 2 >= PRO_BYTES;
constexpr size_t PRO_WXKV = PRO_IN_OUT ? (size_t)T * D * 2 : WS_END0;
constexpr size_t PRO_MEMN = PRO_WXKV + (size_t)DEPTH * 2048 * D * 2;
constexpr size_t WS_END1 = PRO_IN_OUT ? WS_END0 : WS_END0 + PRO_BYTES;
constexpr size_t ABS_BYTES = (size_t)2 * DEPTH * BATCH * D * D * 2;
constexpr bool ABS_IN_OUT = PRO_IN_OUT && (size_t)T * D * 2 >= PRO_BYTES + ABS_BYTES;
constexpr size_t ABS_MT = ABS_IN_OUT ? PRO_MEMN + (size_t)DEPTH * NMEMROWS * D * 2 : WS_END1;
constexpr size_t ABS_NT = ABS_MT + ABS_BYTES / 2;
constexpr size_t WS_END = ABS_IN_OUT ? WS_END1 : WS_END1 + ABS_BYTES;
constexpr size_t WS_XB2 = WS_NAB;
constexpr size_t WS_H = WS_NAB + (size_t)T * D * 2;
static_assert(WS_H + (size_t)T * FF * 2 <= WS_RSS, "H overlay");
constexpr size_t WS_QX = WS_MLB;
static_assert(CFG_BATCH != 8 || CFG_SEQ != 8192 || WS_END <= 1024 * MiB, "workspace budget");
constexpr int CW_BAR = 4096;

constexpr int RING_BYTES = 131072;
constexpr int WSCR_BYTES = 16640;
constexpr int WSM_OFF = 8 * WSCR_BYTES;
constexpr int MISC_OFF = WSM_OFF + 8 * 1024;
constexpr int RSSL_OFF = MISC_OFF + 1024;
constexpr int STG_OFF = 147456;
constexpr int LDS_BYTES = 163840;
static_assert(MISC_OFF + 256 <= RSSL_OFF && RSSL_OFF + 4096 <= STG_OFF && STG_OFF + 8 * 2048 <= LDS_BYTES, "LDS map");

DEV u32 f2bf(float f) { u32 u = __builtin_bit_cast(u32, f); return (u + 0x7fffu + ((u >> 16) & 1u)) >> 16; }
#ifndef EMU
typedef float f32x2_t __attribute__((ext_vector_type(2)));
typedef __bf16 bf16x2_t __attribute__((ext_vector_type(2)));
DEV u32 pk2(float lo, float hi) { f32x2_t v = {lo, hi}; bf16x2_t b = __builtin_convertvector(v, bf16x2_t); return __builtin_bit_cast(u32, b); }
#else
DEV u32 pk2(float lo, float hi) { return f2bf(lo) | (f2bf(hi) << 16); }
#endif
DEV float bflo(u32 w) { return __builtin_bit_cast(float, w << 16); }
DEV float bfhi(u32 w) { return __builtin_bit_cast(float, w & 0xffff0000u); }
DEV float bf2f(bf16 b) { return __builtin_bit_cast(float, (u32)b << 16); }
DEV bf16x8 pack8(f32x4 a, f32x4 b) { u32x4 w; w.x = pk2(a[0], a[1]); w.y = pk2(a[2], a[3]); w.z = pk2(b[0], b[1]); w.w = pk2(b[2], b[3]); return __builtin_bit_cast(bf16x8, w); }
DEV bf16x8 frag2(u32x2 lo, u32x2 hi) { u32x4 w; w.x = lo.x; w.y = lo.y; w.z = hi.x; w.w = hi.y; return __builtin_bit_cast(bf16x8, w); }
DEV u32 rot16(u32 x) { return (x >> 16) | (x << 16); }
DEV u32x2 rev4(u32x2 v) { u32x2 r; r.x = rot16(v.y); r.y = rot16(v.x); return r; }
DEV u32x4 rev8(u32x4 v) { u32x4 r; r.x = rot16(v.w); r.y = rot16(v.z); r.z = rot16(v.y); r.w = rot16(v.x); return r; }
DEV u32x4 ld16(const void* p) { return *(const u32x4*)p; }
DEV u32x2 ld8(const void* p) { return *(const u32x2*)p; }
DEV bf16x8 ldfrag(const void* p) { return __builtin_bit_cast(bf16x8, *(const u32x4*)p); }
#ifndef EMU
DEV float fexp(float x) { return __expf(x); }
DEV float fexp2(float x) { return __builtin_amdgcn_exp2f(x); }
DEV float frcp(float x) { return __builtin_amdgcn_rcpf(x); }
DEV float frsq(float x) { return __builtin_amdgcn_rsqf(x); }
#else
DEV float fexp(float x) { return expf(x); }
DEV float fexp2(float x) { return exp2f(x); }
DEV float frcp(float x) { return 1.f / x; }
DEV float frsq(float x) { return 1.f / sqrtf(x); }
#endif
DEV float sigmoidf_(float x) { return frcp(1.f + fexp(-x)); }
DEV float logsigmoidf_(float x) { return fminf(x, 0.f) - log1pf(expf(-fabsf(x))); }
DEV float softplusf_(float x) { return fmaxf(x, 0.f) + log1pf(expf(-fabsf(x))); }
#ifndef EMU
DEV f32x4 mfma16(bf16x8 a, bf16x8 b, f32x4 c) { return __builtin_amdgcn_mfma_f32_16x16x32_bf16(a, b, c, 0, 0, 0); }
DEV float shfl_xor_f(float v, int m) { return __shfl_xor(v, m); }
DEV float shfl_f(float v, int src) { return __shfl(v, src); }
DEV float shfl_up_f(float v, int d) { return __shfl_up(v, d); }
DEV float lane63_f(float v) { return __builtin_bit_cast(float, __builtin_amdgcn_readlane(__builtin_bit_cast(int, v), 63)); }
DEV void wave_sync() { __builtin_amdgcn_fence(__ATOMIC_RELEASE, "wavefront"); __builtin_amdgcn_wave_barrier(); __builtin_amdgcn_fence(__ATOMIC_ACQUIRE, "wavefront"); }
DEV int rfl(int v) { return __builtin_amdgcn_readfirstlane(v); }
#define NT_STORE16(p, v) __builtin_nontemporal_store((v), (u32x4*)(p))
#define LAUNDER_V(x) asm volatile("" : "+v"(x))
#define SCHED_FENCE() __builtin_amdgcn_sched_barrier(0)
DEV void lds_barrier() { asm volatile("s_waitcnt lgkmcnt(0)" ::: "memory"); __builtin_amdgcn_s_barrier(); asm volatile("" ::: "memory"); }
DEV int lane_id() { int r; asm volatile("v_mbcnt_lo_u32_b32 %0, -1, 0\n\tv_mbcnt_hi_u32_b32 %0, -1, %0" : "=v"(r)); return r; }
#else
DEV f32x4 mfma16(bf16x8 a, bf16x8 b, f32x4 c) { return emu_mfma16(a, b, c); }
DEV float shfl_xor_f(float v, int m) { return emu_shfl(v, emu_lane() ^ m); }
DEV float shfl_f(float v, int src) { return emu_shfl(v, src); }
DEV float shfl_up_f(float v, int d) { int l = emu_lane(); return emu_shfl(v, l >= d ? l - d : l); }
DEV float lane63_f(float v) { return emu_shfl(v, 63); }
DEV void wave_sync() { emu_wave_sync(); }
DEV int rfl(int v) { return v; }
#define NT_STORE16(p, v) (*(u32x4*)(p) = (v))
#define LAUNDER_V(x) do {} while (0)
#define SCHED_FENCE() do {} while (0)
DEV void lds_barrier() { __syncthreads(); }
DEV int lane_id() { return emu_lane(); }
#endif
typedef short v4i16_t __attribute__((ext_vector_type(4)));
#ifndef EMU
DEV u32x2 lds_tr4(const LAS void* p) { return __builtin_bit_cast(u32x2, __builtin_amdgcn_ds_read_tr16_b64_v4i16((LAS v4i16_t*)p)); }
#else
DEV u32x2 lds_tr4(const void* p) { return emu_tr16(p); }
#endif
DEV float wave_max(float v) {
#pragma unroll
    for (int o = 1; o < 64; o <<= 1) v = fmaxf(v, shfl_xor_f(v, o));
    return v; }
DEV float wave_sum(float v) {
#pragma unroll
    for (int o = 1; o < 64; o <<= 1) v += shfl_xor_f(v, o);
    return v; }
DEV float wave_incl_scan(float v, int lane) {
#pragma unroll
    for (int d = 1; d < 64; d <<= 1) { const float t = shfl_up_f(v, d); if (lane >= d) v += t; }
    return v; }

namespace pg8 {
#define PG8_LAS LAS
typedef unsigned short bf16_t;


constexpr int BM = 256, BK = 64, HALF = 128, HTB = HALF * BK * 2  , STAGE_BYTES = 8 * HTB, NXCD = 8, WGM = 8;

__host__ __device__ __forceinline__ int lds_byte(int r, int c) { const int st = (r >> 4) * 2 + (c >> 5), rr = r & 15, cc = c & 31, ob = rr * 64 + cc * 2; return st * 1024 + (ob ^ (((ob >> 9) & 1) << 5)); }
__host__ __device__ __forceinline__ void stage_rc(int b, int& R, int& C) { const int st = b / 1024, sb = b % 1024, swz = sb ^ (((sb >> 9) & 1) << 5); R = (st >> 1) * 16 + swz / 64; C = (st & 1) * 32 + (swz % 64) / 2; }
__host__ __device__ __forceinline__ int perm32(int rho) { const int n = rho >> 4, i = rho & 15; return 8 * (i >> 2) + 4 * n + (i & 3); }

struct Unit { int pm, pn, bt; };
struct Gemm { const bf16_t* A; const bf16_t* Bt; int M, N, K; };

struct StaticOrder {
    int nM, nN, nwg, G, c, wv;
    int bmode, bdiv;
    __host__ __device__ void init(int M, int N, int G_, int c_) { nM = M / BM; nN = N / BM; nwg = nM * nN; G = G_; c = c_; bmode = 0; bdiv = 1; }
    __host__ __device__ bool next(int i, Unit& u) const {
        const long L = (long)i * G + c; if (L >= nwg) return false;
        int wgid = (int)L; { const int q = nwg / NXCD, r = nwg % NXCD, xcd = wgid % NXCD, off = wgid / NXCD; wgid = (xcd < r ? xcd * (q + 1) : r * (q + 1) + (xcd - r) * q) + off; }
        const int nig = WGM * nN, gid = wgid / nig, fm = gid * WGM, gsz = (nM - fm) < WGM ? (nM - fm) : WGM;
        u.pm = fm + ((wgid % nig) % gsz); u.pn = (wgid % nig) / gsz;
        u.bt = bmode == 0 ? u.pn : (bmode == 1 ? (u.pm / bdiv) * nN + u.pn : (bmode == 2 ? (u.pm & 3) * nN + u.pn : u.pn * 4 + (u.pm >> 2))); return true;
    }
    __device__ __forceinline__ void a_ready(const Unit&) const {}
    __device__ __forceinline__ void done(const Unit&) const {}
};
DEV void row_rstd8_lds(const LAS float* rssl, int rl0, float scale, float (&rs)[8]) {
#pragma unroll
    for (int g = 0; g < 8; ++g) { const f32x4 a = *(const LAS f32x4*)(rssl + (rl0 + (g >> 2) * HALF + (g & 3) * 16) * 4); const float s = (a[0] + a[1]) + (a[2] + a[3]); rs[g] = scale * frsq(s * (1.f / 1024.f) + 1e-6f); }
}
DEV void row_rstd8(const float* rss, int row0, int fq, float scale, float (&rs)[8]) {
    f32x4 a[8];
#pragma unroll
    for (int g = 0; g < 8; ++g) a[g] = *(const f32x4*)(rss + (size_t)(row0 + (g >> 2) * HALF + (g & 3) * 16) * 4);
    SCHED_FENCE();
#pragma unroll
    for (int g = 0; g < 8; ++g) { const float s = (a[g][0] + a[g][1]) + (a[g][2] + a[g][3]); rs[g] = scale / sqrtf(s * (1.f / 1024.f) + 1e-6f); }
}
DEV int stg_off(int r, int p) { return r * 128 + ((p ^ (r & 7)) << 4); }
template <bool NT> DEV void stg_store(LAS unsigned char* stg, int lane, u32x4 w0, u32x4 w1, bf16_t* tile, size_t ldc) {
    const int fr = lane & 15, fq = lane >> 4;
    *(LAS u32x4*)(stg + stg_off(fr, fq)) = w0; *(LAS u32x4*)(stg + stg_off(fr, 4 + fq)) = w1;
    wave_sync();
#pragma unroll
    for (int s_ = 0; s_ < 2; ++s_) { const int r = 8 * s_ + (lane >> 3), p = lane & 7; const u32x4 v = *(const LAS u32x4*)(stg + stg_off(r, p));
        if (NT) NT_STORE16(tile + (size_t)r * ldc + 8 * p, v); else *(u32x4*)(tile + (size_t)r * ldc + 8 * p) = v; }
    wave_sync();
}
DEV u32x4 pack8u(const f32x4 a, const f32x4 b) { u32x4 w; w.x = pk2(a[0], a[1]); w.y = pk2(a[2], a[3]); w.z = pk2(b[0], b[1]); w.w = pk2(b[2], b[3]); return w; }
struct EpiInProj {
    static constexpr bool PERM = true, AFTER_DRAIN = false, RSS_LDS = true;
    bf16_t* nab; bf16_t* mlb; bf16_t* gdb; float* gates; const float* rss; LAS unsigned char* stg0;
    DEV void operator()(const f32x4 (&acc)[2][2][4][2], const Unit& u, int wr, int wc, int fr, int fq) const {
        const int row0 = u.pm * BM + wr * 64 + fr; const int pn = u.pn, lane = fr + 16 * fq; LAS unsigned char* stg = stg0 + (wr * 4 + wc) * 2048;
        const int i5 = pn >= 5, i9 = pn >= 9;
        bf16_t* base = nab + (size_t)i5 * ((WS_MLB - WS_NAB) / 2) + (size_t)i9 * ((WS_GDB - WS_MLB) / 2);
        const int ldc = NAB_LD + i5 * (MLB_LD - NAB_LD) + i9 * (GDB_LD - MLB_LD), colt = (pn - 5 * i5 - 4 * i9) * 256;
        float rsv[8];
        row_rstd8_lds((const LAS float*)(stg0 + (RSSL_OFF - STG_OFF)), wr * 64 + fr, 1.f, rsv);
        if (pn == 4 && wc >= 2) {
            if (wc == 2) {
#pragma unroll
                for (int g = 0; g < 8; ++g) { const int ai = g >> 2, m = g & 3; float* gp = gates + (size_t)(row0 + ai * HALF + m * 16) * GATES_LD + 8 * fq;
#pragma unroll
                    for (int bj = 0; bj < 2; ++bj) { *(f32x4*)(gp + 32 * bj) = acc[ai][bj][m][0] * rsv[g]; *(f32x4*)(gp + 32 * bj + 4) = acc[ai][bj][m][1] * rsv[g]; } } }
            return; }
#pragma unroll
        for (int g = 0; g < 8; ++g) { const int ai = g >> 2, m = g & 3; const float rs = rsv[g];
            stg_store<false>(stg, lane, pack8u(acc[ai][0][m][0] * rs, acc[ai][0][m][1] * rs), pack8u(acc[ai][1][m][0] * rs, acc[ai][1][m][1] * rs),
                             base + (size_t)(u.pm * BM + wr * 64 + ai * HALF + m * 16) * ldc + colt + wc * 64, (size_t)ldc); }
    }
};
struct EpiResid {
    static constexpr bool PERM = true, AFTER_DRAIN = false, RSS_LDS = false;
    bf16_t* x; int ldc; float* rss; LAS unsigned char* stg0; LAS float* xch;
    DEV void operator()(const f32x4 (&acc)[2][2][4][2], const Unit& u, int wr, int wc, int fr, int fq) const {
        const int lane = fr + 16 * fq; LAS unsigned char* stg = stg0 + (wr * 4 + wc) * 2048;
        bf16_t* tile0 = x + (size_t)(u.pm * BM + wr * 64) * ldc + u.pn * BM + wc * 64;
        u32x4 rr[8][2];
#pragma unroll
        for (int g = 0; g < 8; ++g)
#pragma unroll
            for (int s_ = 0; s_ < 2; ++s_) rr[g][s_] = *(const u32x4*)(tile0 + (size_t)((g >> 2) * HALF + (g & 3) * 16 + 8 * s_ + (lane >> 3)) * ldc + 8 * (lane & 7));
#pragma unroll
        for (int g = 0; g < 8; ++g) { const int ai = g >> 2, m = g & 3; const size_t row = (size_t)(u.pm * BM + wr * 64 + ai * HALF + m * 16 + fr); float ss = 0.f;
#pragma unroll
            for (int s_ = 0; s_ < 2; ++s_) *(LAS u32x4*)(stg + stg_off(8 * s_ + (lane >> 3), lane & 7)) = rr[g][s_];
            wave_sync();
            u32x4 w[2];
#pragma unroll
            for (int bj = 0; bj < 2; ++bj) { const u32x4 r = *(const LAS u32x4*)(stg + stg_off(fr, 4 * bj + fq));
                const f32x4 v0 = (f32x4){bflo(r.x), bfhi(r.x), bflo(r.y), bfhi(r.y)} + acc[ai][bj][m][0], v1 = (f32x4){bflo(r.z), bfhi(r.z), bflo(r.w), bfhi(r.w)} + acc[ai][bj][m][1];
                w[bj] = pack8u(v0, v1);
                ss += ((v0[0] * v0[0] + v0[1] * v0[1]) + (v0[2] * v0[2] + v0[3] * v0[3])) + ((v1[0] * v1[0] + v1[1] * v1[1]) + (v1[2] * v1[2] + v1[3] * v1[3])); }
            wave_sync();
            stg_store<false>(stg, lane, w[0], w[1], tile0 + (size_t)(ai * HALF + m * 16) * ldc, (size_t)ldc);
            ss += shfl_xor_f(ss, 16); ss += shfl_xor_f(ss, 32);
            if (fq == 0) xch[(wr * 64 + ai * HALF + m * 16 + fr) * 4 + wc] = ss; }
        lds_barrier();
        if (wc == 0) {
#pragma unroll
            for (int ai = 0; ai < 2; ++ai) { const int rl = wr * 64 + ai * HALF + lane; const f32x4 a = *(const LAS f32x4*)(xch + rl * 4);
                rss[(size_t)(u.pm * BM + rl) * 4 + u.pn] = (a[0] + a[1]) + (a[2] + a[3]); } }
    }
};
template <int ACT, int MODE = 0> struct EpiBf16 {
    static constexpr bool PERM = true, AFTER_DRAIN = false, RSS_LDS = (ACT == 1);
    bf16_t* O; int ldc; const float* rss; bf16_t* O2; LAS unsigned char* stg0;
    DEV void operator()(const f32x4 (&acc)[2][2][4][2], const Unit& u, int wr, int wc, int fr, int fq) const {
        int rowb = u.pm * BM, colb = u.pn * BM; bf16_t* O = this->O; const int lane = fr + 16 * fq; LAS unsigned char* stg = stg0 + (wr * 4 + wc) * 2048;
        if (MODE == 1) { rowb = (u.pm & 3) * BM; colb = (u.pm >> 2) * BM; O += (size_t)u.pn * D * D; }
        if (MODE == 2) { rowb = 0; colb = 0; O = ((u.pn >> 2) ? O2 : O) + (size_t)(u.pm * 4 + (u.pn & 3)) * (BM * BM); }
        float rsv[8];
        if (ACT == 1) row_rstd8_lds((const LAS float*)(stg0 + (RSSL_OFF - STG_OFF)), wr * 64 + fr, 1.f, rsv);
        else {
#pragma unroll
            for (int g = 0; g < 8; ++g) rsv[g] = 1.f; }
#pragma unroll
        for (int g = 0; g < 8; ++g) { const int ai = g >> 2, m = g & 3; const float rs = rsv[g]; u32x4 w[2];
#pragma unroll
            for (int bj = 0; bj < 2; ++bj) { f32x4 v0 = acc[ai][bj][m][0] * rs, v1 = acc[ai][bj][m][1] * rs;
                if (ACT == 1) {
#pragma unroll
                    for (int j = 0; j < 4; ++j) { const float a = fmaxf(v0[j], 0.f), b = fmaxf(v1[j], 0.f); v0[j] = a * a; v1[j] = b * b; } }
                w[bj] = pack8u(v0, v1); }
            stg_store<ACT == 1>(stg, lane, w[0], w[1], O + (size_t)(rowb + wr * 64 + ai * HALF + m * 16) * ldc + colb + wc * 64, (size_t)ldc); }
    }
};
struct EpiSoftmax {
    static constexpr bool PERM = true, AFTER_DRAIN = false, RSS_LDS = true;
    bf16_t* P; const float* rss; LAS float* xch; LAS unsigned char* stg0;
    DEV void operator()(f32x4 (&acc)[2][2][4][2], const Unit& u, int wr, int wc, int fr, int fq) const {
        const int rl0 = wr * 64 + fr, lane = fr + 16 * fq; LAS unsigned char* stg = stg0 + (wr * 4 + wc) * 2048;
        float mw[8];
        row_rstd8_lds((const LAS float*)(stg0 + (RSSL_OFF - STG_OFF)), rl0, 1.44269504088896f, mw);
#pragma unroll
        for (int g = 0; g < 8; ++g) { const int ai = g >> 2, m = g & 3, rl = rl0 + ai * HALF + m * 16;
            const float rs = mw[g]; float mx = -3.0e38f;
#pragma unroll
            for (int bj = 0; bj < 2; ++bj)
#pragma unroll
                for (int n = 0; n < 2; ++n) { const f32x4 v = acc[ai][bj][m][n] * rs; acc[ai][bj][m][n] = v; mx = fmaxf(fmaxf(mx, fmaxf(v[0], v[1])), fmaxf(v[2], v[3])); }
            mx = fmaxf(mx, shfl_xor_f(mx, 16)); mx = fmaxf(mx, shfl_xor_f(mx, 32)); float sm = 0.f;
#pragma unroll
            for (int bj = 0; bj < 2; ++bj)
#pragma unroll
                for (int n = 0; n < 2; ++n) { f32x4 v = acc[ai][bj][m][n];
#pragma unroll
                    for (int j = 0; j < 4; ++j) v[j] = fexp2(v[j] - mx);
                    acc[ai][bj][m][n] = v; sm += (v[0] + v[1]) + (v[2] + v[3]); }
            sm += shfl_xor_f(sm, 16); sm += shfl_xor_f(sm, 32); mw[g] = mx;
            if (fq == 0) { LAS float* xp = xch + (rl * 4 + wc) * 2; xp[0] = mx; xp[1] = sm; } }
        lds_barrier();
#pragma unroll
        for (int g = 0; g < 8; ++g) { const int ai = g >> 2, m = g & 3, rl = rl0 + ai * HALF + m * 16;
            const f32x4 a = *(const LAS f32x4*)(xch + rl * 8), b = *(const LAS f32x4*)(xch + rl * 8 + 4);
            const float M = fmaxf(fmaxf(a[0], a[2]), fmaxf(b[0], b[2]));
            const float L = (a[1] * fexp2(a[0] - M) + a[3] * fexp2(a[2] - M)) + (b[1] * fexp2(b[0] - M) + b[3] * fexp2(b[2] - M));
            const float sc = fexp2(mw[g] - M) * frcp(L);
            stg_store<false>(stg, lane, pack8u(acc[ai][0][m][0] * sc, acc[ai][0][m][1] * sc), pack8u(acc[ai][1][m][0] * sc, acc[ai][1][m][1] * sc),
                             P + (size_t)(u.pm * BM + wr * 64 + ai * HALF + m * 16) * D + u.pn * BM + wc * 64, (size_t)D); }
    }
};
#ifdef EMU
template <class Epi, class Sched, bool ALIGN_EPI = false, bool SP2 = false>
inline void gemm_phase(unsigned char* lds, const Gemm g, const Sched& S, const Epi& E) {
    const int tid = threadIdx.x, wid = tid >> 6, lane = tid & 63, wr = wid >> 2, wc = wid & 3, fr = lane & 15, fq = lane >> 4;
    Unit u;
    for (int i = 0; S.next(i, u); ++i) {
        const float* tile = emu_gemm_tile(g.A, g.Bt, g.K, u.pm, u.bt);
        f32x4 acc[2][2][4][2];
        for (int ai = 0; ai < 2; ++ai) for (int bj = 0; bj < 2; ++bj) for (int m = 0; m < 4; ++m) for (int n = 0; n < 2; ++n) for (int j = 0; j < 4; ++j) {
            const int r = 128 * ai + 64 * wr + 16 * m + fr; const int c = Epi::PERM ? 64 * wc + 32 * bj + 8 * fq + 4 * n + j : 128 * bj + 32 * wc + 16 * n + 4 * fq + j;
            acc[ai][bj][m][n][j] = tile[r * 256 + c]; }
        if constexpr (Epi::RSS_LDS) { for (int i = tid; i < 1024; i += 512) ((float*)(lds + RSSL_OFF))[i] = E.rss[(size_t)u.pm * 1024 + i]; __syncthreads(); }
        E(acc, u, wr, wc, fr, fq);
        __syncthreads();
    }
    __syncthreads();
}
}
#endif
#ifndef EMU
template <class Epi, class Sched, bool ALIGN_EPI = false, bool SP2 = false>
__device__ __forceinline__ void gemm_phase(PG8_LAS unsigned char* lds, const Gemm g, const Sched& S, const Epi& E) {
    int tid_l = S.wv * 64 + lane_id(); asm volatile("" : "+v"(tid_l));
    const int tid = tid_l, wid = __builtin_amdgcn_readfirstlane(tid >> 6), lane = tid & 63, wr = wid >> 2, wc = wid & 3, fr = lane & 15, fq = lane >> 4;
    const int K = g.K, nt = K / BK;
    unsigned voffA[2], voffB[2];
#pragma unroll
    for (int i = 0; i < 2; ++i) { int R, C; stage_rc(tid * 16 + i * 8192, R, C); const int Rb = Epi::PERM ? (64 * (R >> 5) + perm32(R & 31)) : R;
        voffA[i] = (unsigned)(R * K + C) * 2u; voffB[i] = (unsigned)(Rb * K + C) * 2u; }
    const size_t kstep = (size_t)(BK * 2);
    const size_t hstep = (size_t)HALF * K * 2;
    const size_t hstepB = Epi::PERM ? (size_t)32 * K * 2 : hstep;
    const size_t tstep = 2 * hstep;
    const unsigned ldsw = (unsigned)wid * 1024u;
    const int aoff = lds_byte(wr * 64 + fr, fq * 8), boff = lds_byte(wc * 32 + fr, fq * 8);
#define PG8_SA(b, h) (((b) * 2 + (h)) * HTB)
#define PG8_SB(b, h) ((4 + (b) * 2 + (h)) * HTB)
#define PG8_STAGE(bufoff, gbase, voff) do { _Pragma("unroll") for (int _i = 0; _i < 2; ++_i) \
        __builtin_amdgcn_global_load_lds((const unsigned*)((const char*)(gbase) + (voff)[_i]), (PG8_LAS unsigned*)(lds + (bufoff) + ldsw + _i * 8192), 16, 0, 0); } while (0)
#define PG8_LDA(dst, b, h) do { _Pragma("unroll") for (int m = 0; m < 4; ++m) _Pragma("unroll") for (int k = 0; k < 2; ++k) dst[m][k] = *(const PG8_LAS bf16x8*)(lds + PG8_SA(b, h) + aoff + m * 2048 + k * 1024); } while (0)
#define PG8_LDB(dst, b, h) do { _Pragma("unroll") for (int n = 0; n < 2; ++n) _Pragma("unroll") for (int k = 0; k < 2; ++k) dst[n][k] = *(const PG8_LAS bf16x8*)(lds + PG8_SB(b, h) + boff + n * 2048 + k * 1024); } while (0)
#define PG8_MMA(ai, bj, At, Bt) do { __builtin_amdgcn_s_setprio(1); _Pragma("unroll") for (int m = 0; m < 4; ++m) _Pragma("unroll") for (int n = 0; n < 2; ++n) _Pragma("unroll") for (int k = 0; k < 2; ++k) \
        acc[ai][bj][m][n] = __builtin_amdgcn_mfma_f32_16x16x32_bf16(Bt[n][k], At[m][k], acc[ai][bj][m][n], 0, 0, 0); __builtin_amdgcn_s_setprio(0); } while (0)
#define PG8_WAIT_V(n) asm volatile("s_waitcnt vmcnt(" #n ")" ::: "memory")
#define PG8_WAIT_L(n) asm volatile("s_waitcnt lgkmcnt(" #n ")" ::: "memory")
#define PG8_BAR __builtin_amdgcn_s_barrier()
#define PG8_SCHED __builtin_amdgcn_sched_barrier(0)
    Unit cur, nxt; int ui = 0;
    if (!S.next(0, cur)) return;
    f32x4 acc[2][2][4][2];
#pragma unroll
    for (int a = 0; a < 2; ++a)
#pragma unroll
        for (int b = 0; b < 2; ++b)
#pragma unroll
            for (int m = 0; m < 4; ++m)
#pragma unroll
                for (int n = 0; n < 2; ++n) acc[a][b][m][n] = (f32x4){0.f, 0.f, 0.f, 0.f};
    bf16x8 At[4][2], B0[2][2], B1[2][2];
    const char* cA = (const char*)g.A + (size_t)cur.pm * tstep; const char* cB = (const char*)g.Bt + (size_t)cur.bt * tstep;
    S.a_ready(cur);
    if constexpr (SP2) {
        PG8_STAGE(PG8_SB(0, 0), cB, voffB); PG8_STAGE(PG8_SB(0, 1), cB + hstepB, voffB); PG8_STAGE(PG8_SA(0, 0), cA, voffA); PG8_STAGE(PG8_SA(0, 1), cA + hstep, voffA);
        if (wr == 1) PG8_BAR;
        PG8_WAIT_V(2); PG8_BAR;
        PG8_STAGE(PG8_SB(1, 0), cB + kstep, voffB); PG8_STAGE(PG8_SA(1, 0), cA + kstep, voffA); PG8_STAGE(PG8_SB(1, 1), cB + hstepB + kstep, voffB);
        PG8_WAIT_V(6); PG8_BAR;
    } else {
        PG8_STAGE(PG8_SB(0, 0), cB, voffB); PG8_STAGE(PG8_SA(0, 0), cA, voffA); PG8_STAGE(PG8_SB(0, 1), cB + hstepB, voffB); PG8_STAGE(PG8_SA(0, 1), cA + hstep, voffA);
        if (wr == 1) PG8_BAR;
        PG8_WAIT_V(4); PG8_BAR;
        PG8_STAGE(PG8_SB(1, 0), cB + kstep, voffB); PG8_STAGE(PG8_SA(1, 0), cA + kstep, voffA); PG8_STAGE(PG8_SB(1, 1), cB + hstepB + kstep, voffB);
        PG8_WAIT_V(6); PG8_BAR;
    }
    for (;;) {
        const bool has_next = S.next(ui + 1, nxt);
        const char* nA = has_next ? (const char*)g.A + (size_t)nxt.pm * tstep : cA; const char* nB = has_next ? (const char*)g.Bt + (size_t)nxt.bt * tstep : cB;
        for (int t = 0; t < nt; t += 2) {
            const bool last = (t == nt - 2);
            const char* a1 = cA + (size_t)(t + 1) * kstep;
            const char* a2 = last ? nA : cA + (size_t)(t + 2) * kstep; const char* b2 = last ? nB : cB + (size_t)(t + 2) * kstep;
            const char* a3 = a2 + kstep; const char* b3 = b2 + kstep;
            if (last && has_next) S.a_ready(nxt);
            if constexpr (Epi::RSS_LDS) {
                if (last && wid < 4) __builtin_amdgcn_global_load_lds((const unsigned*)((const char*)E.rss + ((size_t)cur.pm * BM + wid * 64 + lane) * 16), (PG8_LAS unsigned*)(lds + RSSL_OFF + wid * 1024), 16, 0, 0); }
            if constexpr (SP2) {
            PG8_LDB(B0, 0, 0); PG8_LDB(B1, 0, 1); PG8_SCHED; PG8_LDA(At, 0, 0); PG8_STAGE(PG8_SA(1, 1), a1 + hstep, voffA);
            PG8_WAIT_V(8); PG8_WAIT_L(0); PG8_BAR; PG8_MMA(0, 0, At, B0); PG8_MMA(0, 1, At, B1); PG8_BAR; PG8_SCHED;
            PG8_LDA(At, 0, 1); PG8_STAGE(PG8_SB(0, 0), b2, voffB); PG8_STAGE(PG8_SB(0, 1), b2 + hstepB, voffB); PG8_STAGE(PG8_SA(0, 0), a2, voffA);
            PG8_WAIT_V(8); PG8_WAIT_L(0); PG8_BAR; PG8_MMA(1, 0, At, B0); PG8_MMA(1, 1, At, B1); PG8_BAR; PG8_SCHED;
            PG8_LDB(B0, 1, 0); PG8_LDB(B1, 1, 1); PG8_SCHED; PG8_LDA(At, 1, 0); PG8_STAGE(PG8_SA(0, 1), a2 + hstep, voffA);
            PG8_WAIT_V(8); PG8_WAIT_L(0); PG8_BAR; PG8_MMA(0, 0, At, B0); PG8_MMA(0, 1, At, B1); PG8_BAR; PG8_SCHED;
            PG8_LDA(At, 1, 1); PG8_STAGE(PG8_SB(1, 0), b3, voffB); PG8_STAGE(PG8_SB(1, 1), b3 + hstepB, voffB); PG8_STAGE(PG8_SA(1, 0), a3, voffA);
            PG8_WAIT_V(8); PG8_WAIT_L(0); PG8_BAR; PG8_MMA(1, 0, At, B0); PG8_MMA(1, 1, At, B1); PG8_BAR; PG8_SCHED;
            } else {
            PG8_LDB(B0, 0, 0); PG8_SCHED; PG8_LDA(At, 0, 0); PG8_STAGE(PG8_SA(1, 1), a1 + hstep, voffA);
            PG8_WAIT_L(8); PG8_BAR; PG8_WAIT_L(0); PG8_MMA(0, 0, At, B0); PG8_BAR; PG8_SCHED;
            PG8_LDB(B1, 0, 1); PG8_STAGE(PG8_SB(0, 0), b2, voffB);
            PG8_BAR; PG8_WAIT_L(0); PG8_MMA(0, 1, At, B1); PG8_BAR;
            PG8_LDA(At, 0, 1); PG8_STAGE(PG8_SA(0, 0), a2, voffA);
            PG8_BAR; PG8_WAIT_L(0); PG8_MMA(1, 0, At, B0); PG8_BAR; PG8_SCHED;
            PG8_STAGE(PG8_SB(0, 1), b2 + hstepB, voffB);
            PG8_WAIT_V(6); PG8_BAR; PG8_MMA(1, 1, At, B1); PG8_BAR;
            PG8_LDB(B0, 1, 0); PG8_SCHED; PG8_LDA(At, 1, 0); PG8_STAGE(PG8_SA(0, 1), a2 + hstep, voffA);
            PG8_WAIT_L(8); PG8_BAR; PG8_WAIT_L(0); PG8_MMA(0, 0, At, B0); PG8_BAR; PG8_SCHED;
            PG8_LDB(B1, 1, 1); PG8_STAGE(PG8_SB(1, 0), b3, voffB);
            PG8_BAR; PG8_WAIT_L(0); PG8_MMA(0, 1, At, B1); PG8_BAR;
            PG8_LDA(At, 1, 1); PG8_STAGE(PG8_SA(1, 0), a3, voffA);
            PG8_BAR; PG8_WAIT_L(0); PG8_MMA(1, 0, At, B0); PG8_BAR; PG8_SCHED;
            PG8_STAGE(PG8_SB(1, 1), b3 + hstepB, voffB);
            PG8_WAIT_V(6); PG8_BAR; PG8_MMA(1, 1, At, B1); PG8_BAR;
            }
        }
        if constexpr (ALIGN_EPI) { if (wr == 0) PG8_BAR; }
        if constexpr (!Epi::AFTER_DRAIN) { E(acc, cur, wr, wc, fr, fq); S.done(cur); }
        if (!has_next) break;
#pragma unroll
        for (int a = 0; a < 2; ++a)
#pragma unroll
            for (int b = 0; b < 2; ++b)
#pragma unroll
                for (int m = 0; m < 4; ++m)
#pragma unroll
                    for (int n = 0; n < 2; ++n) acc[a][b][m][n] = (f32x4){0.f, 0.f, 0.f, 0.f};
        cur = nxt; cA = nA; cB = nB; ++ui;
        if constexpr (ALIGN_EPI) { if (wr == 1) PG8_BAR; }
    }
    PG8_WAIT_V(0);
    if constexpr (!ALIGN_EPI) { if (wr == 0) PG8_BAR; }
    PG8_BAR;
    if constexpr (Epi::AFTER_DRAIN) { E.fused(acc, cur, wr, wc, fr, fq, lds, wid, lane); S.done(cur); }
#undef PG8_SA
#undef PG8_SB
#undef PG8_STAGE
#undef PG8_LDA
#undef PG8_LDB
#undef PG8_MMA
#undef PG8_WAIT_V
#undef PG8_WAIT_L
#undef PG8_BAR
#undef PG8_SCHED
}
}
#endif
#ifndef EMU
#define XB_TMO      128
#define XB_XCNT(j)  (256  + 64 * (j))
#define XB_XSUB(j)  (1280 + 64 * (j))
#define XB_XGEN(j)  (2304 + 64 * (j))
#define XB_TOP      3328
#define XB_TOPGEN   3392
#define XCD_BAR_WORDS 3456
#define XB_SPIN_CAP (1u << 18)

__device__ __forceinline__ unsigned xb_ld(unsigned* p)              { return __hip_atomic_load(p, __ATOMIC_RELAXED, __HIP_MEMORY_SCOPE_AGENT); }
__device__ __forceinline__ unsigned xb_add(unsigned* p, unsigned v) { return __hip_atomic_fetch_add(p, v, __ATOMIC_RELAXED, __HIP_MEMORY_SCOPE_AGENT); }
__device__ __forceinline__ unsigned xb_xcc_id() { return (unsigned)__builtin_amdgcn_s_getreg((3 << 11) | 20) & 0xFu; }
#define XB_SPIN(cond, bar) do { unsigned _sp = 0; while (cond) { __builtin_amdgcn_s_sleep(1); \
    if ((++_sp & 255u) == 0u) { if (xb_ld(&(bar)[XB_TMO])) break; if (_sp > XB_SPIN_CAP) { atomicAdd(&(bar)[XB_TMO], 1u); break; } } } } while (0)

struct XcdBarrier {
    int wv;
    unsigned* bar; unsigned x;
    volatile LAS unsigned* st;
};

__device__ __forceinline__ XcdBarrier xcd_barrier_post(unsigned* bar, volatile LAS unsigned* st) {
    XcdBarrier b; b.wv = __builtin_amdgcn_readfirstlane(threadIdx.x >> 6); b.bar = bar; b.x = xb_xcc_id(); b.st = st;
    if (threadIdx.x == 0) (void)xb_add(&bar[XB_XCNT(b.x)], 1u);
    return b;
}
__device__ __forceinline__ void xcd_barrier_complete(unsigned* bar, unsigned x, unsigned& nloc, unsigned& nx) {
    const unsigned G = gridDim.x * gridDim.y * gridDim.z;
    unsigned sum, cnt, mine, sp = 0u;
    for (;;) {
        sum = 0u; cnt = 0u; mine = 0u;
#pragma unroll
        for (unsigned j = 0; j < 16; ++j) { const unsigned c = xb_ld(&bar[XB_XCNT(j)]); sum += c; cnt += (c > 0u) ? 1u : 0u; mine = (j == x) ? c : mine; }
        if (sum == G) break;
        __builtin_amdgcn_s_sleep(1);
        if ((++sp & 255u) == 0u) { if (xb_ld(&bar[XB_TMO])) break; if (sp > XB_SPIN_CAP) { atomicAdd(&bar[XB_TMO], 1u); break; } }
    }
    nloc = mine > 0u ? mine : 1u; nx = cnt > 0u ? cnt : 1u;
}

__device__ __forceinline__ void xcd_barrier(const XcdBarrier& b) {
    asm volatile("s_waitcnt vmcnt(0)" ::: "memory");
    __syncthreads();
    if (b.wv == 0 && lane_id() == 0) {
        unsigned* bar = b.bar;
        __builtin_amdgcn_s_waitcnt(0);
        unsigned nloc = b.st[0], nx = b.st[1];
        if (nloc == 0u) { xcd_barrier_complete(bar, b.x, nloc, nx); b.st[0] = nloc; b.st[1] = nx; }
        const unsigned old = xb_add(&bar[XB_XSUB(b.x)], 1u);
        const unsigned gen = old / nloc;
        if (old + 1u == (gen + 1u) * nloc) {
            __builtin_amdgcn_fence(__ATOMIC_RELEASE, "agent");
            asm volatile("s_waitcnt vmcnt(0)" ::: "memory");
            const unsigned og = xb_add(&bar[XB_TOP], 1u);
            const unsigned tg = og / nx;
            if (og + 1u == (tg + 1u) * nx) xb_add(&bar[XB_TOPGEN], 1u);
            else XB_SPIN(xb_ld(&bar[XB_TOPGEN]) == tg, bar);
            __builtin_amdgcn_fence(__ATOMIC_ACQUIRE, "agent");
            xb_add(&bar[XB_XGEN(b.x)], 1u);
            asm volatile("s_waitcnt vmcnt(0)" ::: "memory");
        } else {
            XB_SPIN(xb_ld(&bar[XB_XGEN(b.x)]) == gen, bar);
            __builtin_amdgcn_fence(__ATOMIC_ACQUIRE, "agent");
            asm volatile("s_waitcnt vmcnt(0)" ::: "memory");
        }
    }
    __syncthreads();
}

__device__ __forceinline__ void sub_barrier(unsigned* ctr, unsigned n, unsigned* tmo, bool leader) {
    asm volatile("s_waitcnt vmcnt(0)" ::: "memory");
    __syncthreads();
    if (leader) {
        __builtin_amdgcn_s_waitcnt(0);
        __builtin_amdgcn_fence(__ATOMIC_RELEASE, "agent");
        asm volatile("s_waitcnt vmcnt(0)" ::: "memory");
        (void)xb_add(ctr, 1u);
        unsigned sp = 0u;
        while (xb_ld(ctr) < n) { __builtin_amdgcn_s_sleep(1); if ((++sp & 255u) == 0u) { if (xb_ld(tmo)) break; if (sp > XB_SPIN_CAP) { atomicAdd(tmo, 1u); break; } } }
        __builtin_amdgcn_fence(__ATOMIC_ACQUIRE, "agent");
        asm volatile("s_waitcnt vmcnt(0)" ::: "memory");
    }
    __syncthreads();
}
#endif
DEV void p0_transpose_item(const float* W, int K, int N, int src_n0, bf16* WT, int dst_n0, LAS float* scr, int kb, int lane, const float* gain) {
    const int k0 = 64 * kb;
    if ((((size_t)W) & 15) == 0 && (N & 3) == 0 && (src_n0 & 3) == 0) {
        f32x4 v[8];
#pragma unroll
        for (int i = 0; i < 8; ++i) v[i] = *(const f32x4*)(W + (size_t)(k0 + 8 * i + (lane >> 3)) * N + src_n0 + 4 * (lane & 7));
#pragma unroll
        for (int i = 0; i < 8; ++i) { const int kk = 8 * i + (lane >> 3); const float gk = gain ? gain[k0 + kk] : 1.f;
#pragma unroll
            for (int j = 0; j < 4; ++j) scr[kk * 33 + 4 * (lane & 7) + j] = v[i][j] * gk; }
    } else {
#pragma unroll 8
        for (int i = 0; i < 32; ++i) { const int kk = 2 * i + (lane >> 5); scr[kk * 33 + (lane & 31)] = W[(size_t)(k0 + kk) * N + src_n0 + (lane & 31)] * (gain ? gain[k0 + kk] : 1.f); }
    }
    wave_sync();
    const int c = lane & 7;
#pragma unroll
    for (int j = 0; j < 4; ++j) { const int n = (lane >> 3) + 8 * j; const LAS float* s = scr + (8 * c) * 33 + n;
        u32x4 o; o.x = pk2(s[0 * 33], s[1 * 33]); o.y = pk2(s[2 * 33], s[3 * 33]); o.z = pk2(s[4 * 33], s[5 * 33]); o.w = pk2(s[6 * 33], s[7 * 33]);
        *(u32x4*)(WT + (size_t)(dst_n0 + n) * K + k0 + 8 * c) = o; }
    wave_sync();
}
DEV int p0_first(int gw, int NGW, int base) { return (gw + NGW - base % NGW) % NGW; }
DEV void p0_transpose_seg(const float* W, int K, int N, int src_n0, int nseg, bf16* WT, int dst_n0, LAS float* scr, int gw, int NGW, int lane, int& base, const float* gain = nullptr) {
    const int nkb = K / 64, nnb = nseg / 32; const int g0 = p0_first(gw, NGW, base); base += nkb * nnb;
    for (int it = g0; it < nkb * nnb; it += NGW) { const int kb = it / nnb, nb = it % nnb; p0_transpose_item(W, K, N, src_n0 + 32 * nb, WT, dst_n0 + 32 * nb, scr, kb, lane, gain); }
}
DEV void rms_row_to_bf16(const float* xrow, const float* w, bf16* orow, int lane) {
    const f32x4* xr = (const f32x4*)xrow + lane; const f32x4* wr = (const f32x4*)w + lane;
    f32x4 v[4]; float s = 0.f;
#pragma unroll
    for (int j = 0; j < 4; ++j) { v[j] = xr[64 * j]; s += (v[j][0] * v[j][0] + v[j][1] * v[j][1]) + (v[j][2] * v[j][2] + v[j][3] * v[j][3]); }
    const float rstd = 1.f / sqrtf(wave_sum(s) * (1.f / D) + EPS);
    u32x2* o8 = (u32x2*)orow + lane;
#pragma unroll
    for (int j = 0; j < 4; ++j) { const f32x4 g = wr[64 * j]; u32x2 o; o.x = pk2(v[j][0] * rstd * g[0], v[j][1] * rstd * g[1]); o.y = pk2(v[j][2] * rstd * g[2], v[j][3] * rstd * g[3]); o8[64 * j] = o; }
}
DEV void rms_row_to_f32(const bf16* xrow, const float* w, float* orow, int lane) {
    const u32x2* xr = (const u32x2*)xrow + lane; const f32x4* wr = (const f32x4*)w + lane;
    f32x4 v[4]; float s = 0.f;
#pragma unroll
    for (int j = 0; j < 4; ++j) { const u32x2 t = xr[64 * j]; v[j] = (f32x4){bflo(t.x), bfhi(t.x), bflo(t.y), bfhi(t.y)}; s += (v[j][0] * v[j][0] + v[j][1] * v[j][1]) + (v[j][2] * v[j][2] + v[j][3] * v[j][3]); }
    const float rstd = 1.f / sqrtf(wave_sum(s) * (1.f / D) + EPS);
    f32x4* o = (f32x4*)orow + lane;
#pragma unroll
    for (int j = 0; j < 4; ++j) { const f32x4 g = wr[64 * j]; o[64 * j] = v[j] * rstd * g; }
}
DEV void phase_norm_bf16(const float* x, const float* w, bf16* out, int rows, int gw, int NGW, int lane, int& base) {
    const int g0 = p0_first(gw, NGW, base); base += rows;
    for (int m = g0; m < rows; m += NGW) rms_row_to_bf16(x + (size_t)m * D, w, out + (size_t)m * D, lane);
}

struct P0Args { const float* w_in; const float* w_out; const float* w_xq; const float* w_xkv; const float* w_xo; const float* w_ff1; const float* w_ff2;
                const float* x; const float* mem; const float* norm_mix_w; const float* norm_mem_w; const float* norm_xa_w; const float* norm_ffn_w; };
DEV void phase_prologue(const P0Args& a, unsigned char* ws, unsigned char* pro, LAS float* scr, int gw, int NGW, int lane) {
    int base = 0;
    for (int l = 0; l < DEPTH; ++l) {
        const float* win = a.w_in + (size_t)l * D * 3752; bf16* wint = (bf16*)(ws + WS_WIN) + (size_t)l * NPROJ * D;
        const float* gmix = a.norm_mix_w + (size_t)l * D;
        p0_transpose_seg(win, D, 3752, 0, 1152, wint, 0, scr, gw, NGW, lane, base, gmix);
        p0_transpose_seg(win, D, 3752, 1152, 1024, wint, 1280, scr, gw, NGW, lane, base, gmix);
        p0_transpose_seg(win, D, 3752, 2192, 1536, wint, 2304, scr, gw, NGW, lane, base, gmix);
        for (int r = p0_first(gw, NGW, base); r < 128; r += NGW) { const int g = r; int src = -1;
            if (g < 8) src = 2176 + g; else if (g < 16) src = 2184 + (g - 8); else if (g < 28) src = 3728 + (g - 16); else if (g < 40) src = 3740 + (g - 28);
            bf16* dst = wint + (size_t)(1152 + r) * D;
            for (int k = lane; k < D; k += 64) dst[k] = (bf16)(src >= 0 ? f2bf(win[(size_t)k * 3752 + src] * gmix[k]) : 0u); }
        base += 128;
        p0_transpose_seg(a.w_out + (size_t)l * D * D, D, D, 0, D, (bf16*)(ws + WS_WOUT) + (size_t)l * D * D, 0, scr, gw, NGW, lane, base);
        { const float* wq = a.w_xq + (size_t)l * D * D; const float* gx = a.norm_xa_w + (size_t)l * D; bf16* wqb = (bf16*)(ws + WS_WXQ) + (size_t)l * D * D;
          for (int c = p0_first(gw, NGW, base); c < D; c += NGW) { const float g = gx[c] * 0.0625f; const f32x4* src = (const f32x4*)(wq + (size_t)c * D + 16 * lane);
              const f32x4 v0 = src[0] * g, v1 = src[1] * g, v2 = src[2] * g, v3 = src[3] * g;
              u32x4 o0, o1; o0.x = pk2(v0[0], v0[1]); o0.y = pk2(v0[2], v0[3]); o0.z = pk2(v1[0], v1[1]); o0.w = pk2(v1[2], v1[3]); o1.x = pk2(v2[0], v2[1]); o1.y = pk2(v2[2], v2[3]); o1.z = pk2(v3[0], v3[1]); o1.w = pk2(v3[2], v3[3]);
              u32x4* dst = (u32x4*)(wqb + ((size_t)(lane >> 4) * D + c) * 256 + 16 * (lane & 15)); dst[0] = o0; dst[1] = o1; } base += D; }
        for (int h = 0; h < 4; ++h) p0_transpose_seg(a.w_xo + (size_t)l * D * D + (size_t)h * 256 * D, 256, D, 0, D, (bf16*)(ws + WS_WXO) + (size_t)l * D * D + (size_t)h * D * 256, 0, scr, gw, NGW, lane, base);
        p0_transpose_seg(a.w_xkv + (size_t)l * D * 2048, D, 2048, 0, 2048, (bf16*)(pro + PRO_WXKV) + (size_t)l * 2048 * D, 0, scr, gw, NGW, lane, base);
        p0_transpose_seg(a.w_ff1 + (size_t)l * D * FF, D, FF, 0, FF, (bf16*)(ws + WS_W1) + (size_t)l * FF * D, 0, scr, gw, NGW, lane, base, a.norm_ffn_w + (size_t)l * D);
        p0_transpose_seg(a.w_ff2 + (size_t)l * FF * D, FF, D, 0, D, (bf16*)(ws + WS_W2) + (size_t)l * D * FF, 0, scr, gw, NGW, lane, base);
        phase_norm_bf16(a.mem, a.norm_mem_w + (size_t)l * D, (bf16*)(pro + PRO_MEMN) + (size_t)l * NMEMROWS * D, NMEMROWS, gw, NGW, lane, base);
    }
    static_assert(T % 2 == 0, "row pairs");
    for (int m = 2 * gw; m < T; m += 2 * NGW) {
        f32x4 v[2][4];
#pragma unroll
        for (int r = 0; r < 2; ++r) { const f32x4* xr = (const f32x4*)(a.x + (size_t)(m + r) * D) + lane;
#pragma unroll
            for (int j = 0; j < 4; ++j) v[r][j] = xr[64 * j]; }
#pragma unroll
        for (int r = 0; r < 2; ++r) { u32x2* o8 = (u32x2*)((bf16*)(ws + WS_XY) + (size_t)(m + r) * D) + lane; float s = 0.f;
#pragma unroll
            for (int j = 0; j < 4; ++j) { const f32x4 t = v[r][j]; u32x2 o; o.x = pk2(t[0], t[1]); o.y = pk2(t[2], t[3]); o8[64 * j] = o;
                const f32x4 q = {bflo(o.x), bfhi(o.x), bflo(o.y), bfhi(o.y)}; s += (q[0] * q[0] + q[1] * q[1]) + (q[2] * q[2] + q[3] * q[3]); }
            s = wave_sum(s); if (lane < 4) ((float*)(ws + WS_RSS))[(size_t)(m + r) * 4 + lane] = (lane == 0) ? s : 0.f; } }
}

DEV void phase_na(const bf16* __restrict__ nab, const LAS float* biasL  , bf16* __restrict__ xy, int gw, int NGW, int lane) {
    const int fr = lane & 15, fq = lane >> 4;
    for (int it = gw; it < (T / 16) * 6; it += NGW) {
        const int h = it % 6, tg = it / 6, token0 = tg * 16, b = token0 / SEQ, s0 = token0 % SEQ, r = s0 / 64, g = (s0 % 64) / 16;
        int r0 = r - 4; r0 = r0 < 0 ? 0 : (r0 > GROWS - 8 ? GROWS - 8 : r0);
        const int cbase = (g == 0) ? 0 : (g == 1 ? 8 : (g == 2 ? 24 : 32));
        const int c = 16 * g + fr; int c0 = c - 8; c0 = c0 < 0 ? 0 : (c0 > 48 ? 48 : c0);
        const bf16* qp = nab + (size_t)(token0 + fr) * NAB_LD + h * 64 + 8 * fq;
        const bf16x8 q0 = ldfrag(qp), q1 = ldfrag(qp + 32);
        f32x4 acc[16];
#pragma unroll
        for (int kt = 0; kt < 16; ++kt) { const int i = kt >> 1, cb = kt & 1;
            const bf16* kp = nab + (size_t)(b * SEQ + (r0 + i) * 64 + cbase + 16 * cb + fr) * NAB_LD + 384 + h * 64 + 8 * fq;
            f32x4 a = {0.f, 0.f, 0.f, 0.f}; a = mfma16(ldfrag(kp), q0, a); a = mfma16(ldfrag(kp + 32), q1, a); acc[kt] = a; }
        float mx = -1e30f;
#pragma unroll
        for (int kt = 0; kt < 16; ++kt) { const int i = kt >> 1, cb = kt & 1; const int dr = r0 + i - r + 7;
#pragma unroll
            for (int j = 0; j < 4; ++j) { const int kc = cbase + 16 * cb + 4 * fq + j; const bool ok = (kc >= c0) && (kc < c0 + 16);
                float x = -1e30f; if (ok) x = acc[kt][j] * 0.125f + biasL[(h * 15 + dr) * 31 + (kc - c + 15)];
                acc[kt][j] = x; mx = fmaxf(mx, x); } }
        mx = fmaxf(mx, shfl_xor_f(mx, 16)); mx = fmaxf(mx, shfl_xor_f(mx, 32));
        float sum = 0.f;
#pragma unroll
        for (int kt = 0; kt < 16; ++kt)
#pragma unroll
            for (int j = 0; j < 4; ++j) { const float p = (acc[kt][j] > -1e29f) ? expf(acc[kt][j] - mx) : 0.f; acc[kt][j] = p; sum += p; }
        sum += shfl_xor_f(sum, 16); sum += shfl_xor_f(sum, 32);
        const float inv = 1.f / sum;
        f32x4 o[4];
#pragma unroll
        for (int dt = 0; dt < 4; ++dt) o[dt] = (f32x4){0.f, 0.f, 0.f, 0.f};
#pragma unroll
        for (int i = 0; i < 8; ++i) { const bf16x8 pf = pack8(acc[2 * i], acc[2 * i + 1]);
            const bf16* vrow = nab + (size_t)(b * SEQ + (r0 + i) * 64 + cbase + 4 * fq) * NAB_LD + 768 + h * 64 + fr;
#pragma unroll
            for (int dt = 0; dt < 4; ++dt) { u32 w[4];
#pragma unroll
                for (int jj = 0; jj < 4; ++jj) { const int j0 = 2 * jj, j1 = 2 * jj + 1;
                    const u32 lo = vrow[(size_t)(16 * (j0 >> 2) + (j0 & 3)) * NAB_LD + 16 * dt], hi = vrow[(size_t)(16 * (j1 >> 2) + (j1 & 3)) * NAB_LD + 16 * dt]; w[jj] = lo | (hi << 16); }
                u32x4 wv; wv.x = w[0]; wv.y = w[1]; wv.z = w[2]; wv.w = w[3];
                o[dt] = mfma16(__builtin_bit_cast(bf16x8, wv), pf, o[dt]); } }
        bf16* op = xy + (size_t)(token0 + fr) * D + h * 64 + 4 * fq;
#pragma unroll
        for (int dt = 0; dt < 4; ++dt) { u32x2 w; w.x = pk2(o[dt][0] * inv, o[dt][1] * inv); w.y = pk2(o[dt][2] * inv, o[dt][3] * inv); *(u32x2*)(op + 16 * dt) = w; }
    }
}

constexpr int NA_STRIPS = 5, NA_BIAS_OFF = RING_BYTES, NA_XO_OFF = WSM_OFF  , NA_XS_OFF = MISC_OFF + 256  ;
static_assert(NA_BIAS_OFF + 15 * 32 * 4 <= NA_XO_OFF && NA_XO_OFF + 8192 <= MISC_OFF && NA_XS_OFF + 2048 <= LDS_BYTES, "NA LDS extras");
DEV int na_r0(int r) { int r0 = r - 4; return r0 < 0 ? 0 : (r0 > GROWS - 8 ? GROWS - 8 : r0); }
DEV void na_row_issue(u32x4 (&r)[2], const bf16* __restrict__ nab, int b, int h, int R, int tid) {
    const int col = tid >> 3, ck = tid & 7; const bf16* p = nab + ((size_t)b * SEQ + R * 64 + col) * NAB_LD + h * 64 + ck * 8; r[0] = ld16(p + 384); r[1] = ld16(p + 768);
}
DEV void na_row_commit(const u32x4 (&r)[2], LAS unsigned char* lds, int R, int tid) {
    const int col = tid >> 3, ck = tid & 7; const int off = (R & 7) * 8192 + col * 128 + ((ck ^ (col & 7)) << 4); *(LAS u32x4*)(lds + off) = r[0]; *(LAS u32x4*)(lds + 65536 + off) = r[1];
}
DEV void na_half(const bf16x8 qa, const bf16x8 qb, const LAS unsigned char* lds, const LAS unsigned char* biasH  , const int (&boff)[8], int r, int g, int hf, int lane,
                 float& mx_out, float& sum_out, f32x4 (&o)[4]) {
    const int fr = lane & 15, fq = lane >> 4;
    const int cbase = (g == 0) ? 0 : (g == 1 ? 8 : (g == 2 ? 24 : 32));
    const int r0 = na_r0(r);
    const int colk = cbase + fr, koff0 = colk * 128 + ((fq ^ (colk & 7)) << 4), koff1 = koff0 ^ 64;
    f32x4 acc[8];
#pragma unroll
    for (int ii = 0; ii < 4; ++ii) { const int so = ((r0 + 4 * hf + ii) & 7) * 8192;
        const LAS unsigned char* k0p = lds + so + koff0; const LAS unsigned char* k1p = lds + so + koff1;
#pragma unroll
        for (int cb = 0; cb < 2; ++cb) { f32x4 a = {0.f, 0.f, 0.f, 0.f};
            a = mfma16(*(const LAS bf16x8*)(k0p + 2048 * cb), qa, a); a = mfma16(*(const LAS bf16x8*)(k1p + 2048 * cb), qb, a); acc[2 * ii + cb] = a; } }
    float mx = -1e30f;
    const int drb = (r0 + 4 * hf - r + 7) * 128;
#pragma unroll
    for (int kt = 0; kt < 8; ++kt)
#pragma unroll
        for (int j = 0; j < 4; ++j) { const float x = acc[kt][j] * 0.125f + *(const LAS float*)(biasH + drb + (kt >> 1) * 128 + boff[4 * (kt & 1) + j]); acc[kt][j] = x; mx = fmaxf(mx, x); }
    mx = fmaxf(mx, shfl_xor_f(mx, 16)); mx = fmaxf(mx, shfl_xor_f(mx, 32));
    float sum = 0.f;
#pragma unroll
    for (int kt = 0; kt < 8; ++kt)
#pragma unroll
        for (int j = 0; j < 4; ++j) { const float p = fexp(acc[kt][j] - mx); acc[kt][j] = p; sum += p; }
    sum += shfl_xor_f(sum, 16); sum += shfl_xor_f(sum, 32);
#pragma unroll
    for (int dt = 0; dt < 4; ++dt) o[dt] = (f32x4){0.f, 0.f, 0.f, 0.f};
    const int kc1 = cbase + 4 * fq + (fr >> 2), pp = fr & 3;
    const int voff0 = 65536 + kc1 * 128 + ((pp & 1) << 3) + (((pp >> 1) ^ (kc1 & 7)) << 4);
#pragma unroll
    for (int ii = 0; ii < 4; ++ii) { const bf16x8 pf = pack8(acc[2 * ii], acc[2 * ii + 1]); const int so = ((r0 + 4 * hf + ii) & 7) * 8192;
#pragma unroll
        for (int dt = 0; dt < 4; ++dt) { const LAS unsigned char* vp = lds + so + (voff0 ^ (dt << 5));
            o[dt] = mfma16(frag2(lds_tr4(vp), lds_tr4(vp + 2048)), pf, o[dt]); } }
    mx_out = mx; sum_out = sum;
}
DEV void phase_na2(const bf16* __restrict__ nab, const float* __restrict__ relbias  , bf16* __restrict__ xy, LAS unsigned char* lds, int bid, int G, int tid) {
    const int wave = rfl(tid >> 6), lane = tid & 63, fr = lane & 15, fq = lane >> 4; const int g = wave & 3, hf = wave >> 2;
    LAS float* biasH = (LAS float*)(lds + NA_BIAS_OFF);
    LAS u32* xo_ = (LAS u32*)(lds + NA_XO_OFF); LAS float* xs_ = (LAS float*)(lds + NA_XS_OFF);
    for (int un = bid; un < BATCH * 6 * NA_STRIPS; un += G) {
        const int st = un % NA_STRIPS, bh = un / NA_STRIPS, h = bh % 6, b = bh / 6, ra = (st * GROWS) / NA_STRIPS, rb = ((st + 1) * GROWS) / NA_STRIPS;
        for (int i = tid; i < 15 * 32; i += NWAVES * 64) biasH[i] = ((i & 31) < 31) ? relbias[h * 465 + (i >> 5) * 31 + (i & 31)] : -1e30f;
        { const int r0 = na_r0(ra);
#pragma unroll 1
          for (int hh = 0; hh < 2; ++hh) { u32x4 kv[8];
#pragma unroll
              for (int i = 0; i < 4; ++i) { const int R = r0 + 4 * hh + i, col = tid >> 3, ck = tid & 7; const bf16* p = nab + ((size_t)b * SEQ + R * 64 + col) * NAB_LD + h * 64 + ck * 8; kv[i] = ld16(p + 384); kv[4 + i] = ld16(p + 768); }
#pragma unroll
              for (int i = 0; i < 4; ++i) { const int R = r0 + 4 * hh + i, col = tid >> 3, ck = tid & 7; const int off = (R & 7) * 8192 + col * 128 + ((ck ^ (col & 7)) << 4);
                  *(LAS u32x4*)(lds + off) = kv[i]; *(LAS u32x4*)(lds + 65536 + off) = kv[4 + i]; } } }
#define NA_NEED(r) (((r) + 1 < rb) && (na_r0((r) + 1) != na_r0(r)))
#define NA_QLOAD(qx0, qx1, r) do { const bf16* qp_ = nab + ((size_t)b * SEQ + (r) * 64 + 16 * g + fr) * NAB_LD + h * 64 + 8 * fq; qx0 = ldfrag(qp_); qx1 = ldfrag(qp_ + 32); } while (0)
#define NA_STEP(r, Q0, Q1, NCUR, NNXT) { \
            if (NA_NEED((r) + 1)) na_row_issue(NNXT, nab, b, h, na_r0((r) + 2) + 7, tid); \
            float mx_, sm_; f32x4 o_[4]; na_half(Q0, Q1, lds, biasB, boff, (r), g, hf, lane, mx_, sm_, o_); \
            if ((r) + 2 < rb) NA_QLOAD(Q0, Q1, (r) + 2); \
            if (hf) { _Pragma("unroll") for (int dt = 0; dt < 4; ++dt) { xo_[((g * 8 + 2 * dt) * 64) + lane] = pk2(o_[dt][0], o_[dt][1]); xo_[((g * 8 + 2 * dt + 1) * 64) + lane] = pk2(o_[dt][2], o_[dt][3]); } \
                      xs_[(g * 2) * 64 + lane] = mx_; xs_[(g * 2 + 1) * 64 + lane] = sm_; } \
            lds_barrier();                                                                     \
            if (!hf) { const float m1 = xs_[(g * 2) * 64 + lane], s1 = xs_[(g * 2 + 1) * 64 + lane]; const float M = fmaxf(mx_, m1), a0 = fexp(mx_ - M), a1 = fexp(m1 - M), inv = frcp(sm_ * a0 + s1 * a1); \
                bf16* op = xy + ((size_t)b * SEQ + (r) * 64 + 16 * g + fr) * D + h * 64 + 4 * fq; \
                _Pragma("unroll") for (int dt = 0; dt < 4; ++dt) { const u32 w0 = xo_[((g * 8 + 2 * dt) * 64) + lane], w1 = xo_[((g * 8 + 2 * dt + 1) * 64) + lane]; \
                    u32x2 w; w.x = pk2((o_[dt][0] * a0 + bflo(w0) * a1) * inv, (o_[dt][1] * a0 + bfhi(w0) * a1) * inv); w.y = pk2((o_[dt][2] * a0 + bflo(w1) * a1) * inv, (o_[dt][3] * a0 + bfhi(w1) * a1) * inv); \
                    *(u32x2*)(op + 16 * dt) = w; } } \
            if (NA_NEED(r)) na_row_commit(NCUR, lds, na_r0((r) + 1) + 7, tid); \
            lds_barrier(); }
        u32x4 nA[2], nB[2]; bf16x8 qA0, qA1, qB0, qB1; int boff[8];
        { const int cbase = (g == 0) ? 0 : (g == 1 ? 8 : (g == 2 ? 24 : 32)); const int c = 16 * g + fr; int c0 = c - 8; c0 = c0 < 0 ? 0 : (c0 > 48 ? 48 : c0);
#pragma unroll
          for (int t = 0; t < 8; ++t) { const int kc = cbase + 16 * (t >> 2) + 4 * fq + (t & 3); boff[t] = 4 * ((kc >= c0 && kc < c0 + 16) ? (kc - c + 15) : 31); } }
        if (NA_NEED(ra)) na_row_issue(nA, nab, b, h, na_r0(ra + 1) + 7, tid);
        NA_QLOAD(qA0, qA1, ra); if (ra + 1 < rb) NA_QLOAD(qB0, qB1, ra + 1);
        lds_barrier();
        const LAS unsigned char* biasB = (const LAS unsigned char*)biasH;
        for (int r = ra; r < rb; r += 2) {
            NA_STEP(r, qA0, qA1, nA, nB)
            if (r + 1 >= rb) break;
            NA_STEP(r + 1, qB0, qB1, nB, nA)
        }
#undef NA_STEP
#undef NA_NEED
#undef NA_QLOAD
    }
}
DEV int ml_item(int b, int h, int dir, int n) { return ((b * 4 + h) * 2 + dir) * NC + n; }
DEV void ml_gates(const float* gates, const float* i_bias, const float* f_bias, int b, int h, int dir, int chunk, int lane, float& bcum, float& ig) {
    const int tok = b * SEQ + chunk * 64 + (dir ? 63 - lane : lane);
    const float fpre = gates[(size_t)tok * GATES_LD + 8 + dir * 4 + h] + f_bias[dir * 4 + h];
    ig = gates[(size_t)tok * GATES_LD + dir * 4 + h] + i_bias[dir * 4 + h];
    bcum = wave_incl_scan(logsigmoidf_(fpre), lane);
}
DEV void phase_ml1(const bf16* mlb, const float* gates, const float* i_bias, const float* f_bias, bf16* cml, float* nml, float* sml, LAS float* wsm, int gw, int NGW, int lane) {
    const int fr = lane & 15, fq = lane >> 4;
    for (int it = gw; it < NITEM_ML; it += NGW) {
        const int dir = it & 1, chunk = (it >> 1) % NC, bh = it / (2 * NC), h = bh & 3, b = bh >> 2, n = dir ? NC - 1 - chunk : chunk;
        float bcum, ig; ml_gates(gates, i_bias, f_bias, b, h, dir, chunk, lane, bcum, ig);
        const float blast = lane63_f(bcum), w = blast - bcum + ig, mloc = wave_max(w);
        wave_sync(); wsm[lane] = expf(w - mloc) * 0.125f; wave_sync();
        const size_t tok0 = (size_t)b * SEQ + chunk * 64;
        bf16x8 af[4][2];
#pragma unroll
        for (int lb = 0; lb < 2; ++lb) { float ws[8]; size_t rowoff[8];
#pragma unroll
            for (int j = 0; j < 8; ++j) { const int lp = 32 * lb + 8 * fq + j; ws[j] = wsm[lp]; rowoff[j] = (tok0 + (dir ? 63 - lp : lp)) * MLB_LD; }
#pragma unroll
            for (int dt = 0; dt < 4; ++dt) { u32 wv[4];
#pragma unroll
                for (int jj = 0; jj < 4; ++jj) { const float lo = bf2f(mlb[rowoff[2 * jj] + 256 + h * 64 + 16 * dt + fr]) * ws[2 * jj], hi = bf2f(mlb[rowoff[2 * jj + 1] + 256 + h * 64 + 16 * dt + fr]) * ws[2 * jj + 1]; wv[jj] = pk2(lo, hi); }
                u32x4 t; t.x = wv[0]; t.y = wv[1]; t.z = wv[2]; t.w = wv[3]; af[dt][lb] = __builtin_bit_cast(bf16x8, t); } }
        f32x4 cacc[4][4], nacc[4];
#pragma unroll
        for (int dt = 0; dt < 4; ++dt) { nacc[dt] = (f32x4){0.f, 0.f, 0.f, 0.f};
#pragma unroll
            for (int et = 0; et < 4; ++et) cacc[dt][et] = (f32x4){0.f, 0.f, 0.f, 0.f}; }
        const u32 one2 = (fr == 0) ? 0x3f803f80u : 0u; u32x4 onev; onev.x = one2; onev.y = one2; onev.z = one2; onev.w = one2; const bf16x8 bone = __builtin_bit_cast(bf16x8, onev);
#pragma unroll
        for (int lb = 0; lb < 2; ++lb) {
#pragma unroll
            for (int et = 0; et < 4; ++et) { u32 wv[4];
#pragma unroll
                for (int jj = 0; jj < 4; ++jj) { const int l0 = 32 * lb + 8 * fq + 2 * jj, l1 = l0 + 1;
                    const u32 lo = mlb[(tok0 + (dir ? 63 - l0 : l0)) * MLB_LD + 512 + h * 64 + 16 * et + fr], hi = mlb[(tok0 + (dir ? 63 - l1 : l1)) * MLB_LD + 512 + h * 64 + 16 * et + fr]; wv[jj] = lo | (hi << 16); }
                u32x4 t; t.x = wv[0]; t.y = wv[1]; t.z = wv[2]; t.w = wv[3]; const bf16x8 bf = __builtin_bit_cast(bf16x8, t);
#pragma unroll
                for (int dt = 0; dt < 4; ++dt) cacc[dt][et] = mfma16(af[dt][lb], bf, cacc[dt][et]); }
#pragma unroll
            for (int dt = 0; dt < 4; ++dt) nacc[dt] = mfma16(af[dt][lb], bone, nacc[dt]); }
        const size_t iti = (size_t)ml_item(b, h, dir, n);
        bf16* cp = cml + iti * 4096;
#pragma unroll
        for (int dt = 0; dt < 4; ++dt)
#pragma unroll
            for (int et = 0; et < 4; ++et) { u32x2 w; w.x = pk2(cacc[dt][et][0], cacc[dt][et][1]); w.y = pk2(cacc[dt][et][2], cacc[dt][et][3]); *(u32x2*)(cp + (16 * et + fr) * 64 + 16 * dt + 4 * fq) = w; }
        if (fr == 0) {
#pragma unroll
            for (int dt = 0; dt < 4; ++dt) *(f32x4*)(nml + iti * 64 + 16 * dt + 4 * fq) = nacc[dt]; }
        if (lane == 0) { sml[iti * 4 + 0] = mloc; sml[iti * 4 + 1] = blast; }
    }
}
DEV void phase_ml2(bf16* cml, float* nml, float* sml, int gtid, int NGT) {
    constexpr int NCHAIN = BATCH * 4 * 2;
    for (int w = gtid; w < NCHAIN * 512 + NCHAIN * 16; w += NGT) {
        if (w < NCHAIN * 512) {
            const int chain = w >> 9, grp = w & 511; float c[8];
#pragma unroll
            for (int j = 0; j < 8; ++j) c[j] = 0.f;
            float m = 0.f;
            for (int n0 = 0; n0 < NC; n0 += 8) { u32x4 ld[8]; float mlv[8], blv[8];
#pragma unroll
                for (int u = 0; u < 8; ++u) { ld[u] = *(const u32x4*)(cml + ((size_t)(chain * NC + n0 + u)) * 4096 + grp * 8); mlv[u] = sml[((size_t)chain * NC + n0 + u) * 4]; blv[u] = sml[((size_t)chain * NC + n0 + u) * 4 + 1]; }
#pragma unroll
                for (int u = 0; u < 8; ++u) { const size_t it = (size_t)chain * NC + n0 + u; const float ml = mlv[u], bl = blv[u];
                    const float mn = fmaxf(bl + m, ml), a = expf(bl + m - mn), g = expf(ml - mn);
                    u32x4 o; o.x = pk2(c[0], c[1]); o.y = pk2(c[2], c[3]); o.z = pk2(c[4], c[5]); o.w = pk2(c[6], c[7]);
                    *(u32x4*)(cml + it * 4096 + grp * 8) = o;
                    const u32 lw[4] = {ld[u].x, ld[u].y, ld[u].z, ld[u].w};
#pragma unroll
                    for (int j = 0; j < 4; ++j) { c[2 * j] = a * c[2 * j] + g * bflo(lw[j]); c[2 * j + 1] = a * c[2 * j + 1] + g * bfhi(lw[j]); }
                    m = mn; } }
        } else {
            const int idx = w - NCHAIN * 512, chain = idx >> 4, grp = idx & 15; f32x4 nv = {0.f, 0.f, 0.f, 0.f}; float m = 0.f;
            for (int n = 0; n < NC; ++n) { const size_t it = (size_t)chain * NC + n; const float ml = sml[it * 4 + 0], bl = sml[it * 4 + 1];
                const float mn = fmaxf(bl + m, ml), a = expf(bl + m - mn), g = expf(ml - mn);
                const f32x4 nl = *(const f32x4*)(nml + it * 64 + grp * 4); *(f32x4*)(nml + it * 64 + grp * 4) = nv;
                if (grp == 0) sml[it * 4 + 2] = m;
                nv = nv * a + nl * g; m = mn; }
        }
    }
}
DEV void phase_ml3(const bf16* mlb, const float* gates, const float* i_bias, const float* f_bias, const float* norm_w, const bf16* cml, const float* nml, const float* sml,
                   bf16* xy, LAS float* hbuf  , LAS float* wsm  , int gw, int NGW, int lane) {
    for (int wi = gw; wi < BATCH * 4 * NC; wi += NGW) {
        int ln_ = lane;
#ifndef EMU
        asm volatile("" : "+v"(ln_));
#endif
        const int fr = ln_ & 15, fq = ln_ >> 4;
        const int chunk = wi % NC, bh = wi / NC, h = bh & 3, b = bh >> 2; const size_t tok0 = (size_t)b * SEQ + chunk * 64;
#pragma unroll 1
        for (int dir = 0; dir < 2; ++dir) {
            const int n = dir ? NC - 1 - chunk : chunk; const size_t it = (size_t)ml_item(b, h, dir, n);
            float bcum, ig; ml_gates(gates, i_bias, f_bias, b, h, dir, chunk, lane, bcum, ig);
            wave_sync(); wsm[lane] = bcum; wsm[64 + lane] = ig; wave_sync();
            const float mprev = sml[it * 4 + 2];
            bf16x8 kf[4][2], vf[4][2], nf[2], qf[4][2];
#pragma unroll
            for (int t4 = 0; t4 < 4; ++t4)
#pragma unroll
                for (int db = 0; db < 2; ++db) { const int sp = 16 * t4 + fr;
                    kf[t4][db] = ldfrag(mlb + (tok0 + (dir ? 63 - sp : sp)) * MLB_LD + 256 + h * 64 + 32 * db + 8 * fq);
                    qf[t4][db] = ldfrag(mlb + (tok0 + (dir ? 63 - sp : sp)) * MLB_LD + h * 64 + 32 * db + 8 * fq); }
#pragma unroll
            for (int db = 0; db < 2; ++db) { u32x4 t = {0u, 0u, 0u, 0u};
                if (fr == 0) { const f32x4 a = *(const f32x4*)(nml + it * 64 + 32 * db + 8 * fq), c = *(const f32x4*)(nml + it * 64 + 32 * db + 8 * fq + 4); t.x = pk2(a[0], a[1]); t.y = pk2(a[2], a[3]); t.z = pk2(c[0], c[1]); t.w = pk2(c[2], c[3]); }
                nf[db] = __builtin_bit_cast(bf16x8, t); }
#pragma unroll
            for (int sb = 0; sb < 2; ++sb) { size_t rowoff[8];
#pragma unroll
                for (int j = 0; j < 8; ++j) { const int sp = 32 * sb + 16 * (j >> 2) + 4 * fq + (j & 3); rowoff[j] = (tok0 + (dir ? 63 - sp : sp)) * MLB_LD + 512 + h * 64 + fr; }
#pragma unroll
                for (int et = 0; et < 4; ++et) { u32x4 t; t.x = (u32)mlb[rowoff[0] + 16 * et] | ((u32)mlb[rowoff[1] + 16 * et] << 16); t.y = (u32)mlb[rowoff[2] + 16 * et] | ((u32)mlb[rowoff[3] + 16 * et] << 16);
                    t.z = (u32)mlb[rowoff[4] + 16 * et] | ((u32)mlb[rowoff[5] + 16 * et] << 16); t.w = (u32)mlb[rowoff[6] + 16 * et] | ((u32)mlb[rowoff[7] + 16 * et] << 16); vf[et][sb] = __builtin_bit_cast(bf16x8, t); } }
            float eg[4][4];
#pragma unroll
            for (int s4 = 0; s4 < 4; ++s4)
#pragma unroll
                for (int j = 0; j < 4; ++j) { const int sp = 16 * s4 + 4 * fq + j; eg[s4][j] = wsm[64 + sp] - wsm[sp]; }
#pragma unroll
            for (int lt = 0; lt < 4; ++lt) {
                const int lp = 16 * lt + fr;
                const bf16x8 q0 = qf[lt][0], q1 = qf[lt][1];
                const float bl = wsm[lp], inter = bl + mprev;
                f32x4 st[4]; float mt = -1e30f;
#pragma unroll
                for (int s4 = 0; s4 < 4; ++s4) {
                    if (s4 <= lt) { f32x4 a = {0.f, 0.f, 0.f, 0.f}; a = mfma16(kf[s4][0], q0, a); a = mfma16(kf[s4][1], q1, a); st[s4] = a;
#pragma unroll
                        for (int j = 0; j < 4; ++j) { float d = bl + eg[s4][j]; if (s4 == lt) d = (4 * fq + j <= fr) ? d : -1e30f; mt = fmaxf(mt, d); } }
                    else st[s4] = (f32x4){0.f, 0.f, 0.f, 0.f}; }
                mt = fmaxf(mt, shfl_xor_f(mt, 16)); mt = fmaxf(mt, shfl_xor_f(mt, 32)); mt = fmaxf(mt, inter);
                float dsum = 0.f;
#pragma unroll
                for (int s4 = 0; s4 < 4; ++s4)
#pragma unroll
                    for (int j = 0; j < 4; ++j) { float d = bl + eg[s4][j]; if (s4 == lt) d = (4 * fq + j <= fr) ? d : -1e30f;
                        const float p = (s4 <= lt) ? st[s4][j] * 0.125f * fexp(d - mt) : 0.f; st[s4][j] = p; dsum += p; }
                dsum += shfl_xor_f(dsum, 16); dsum += shfl_xor_f(dsum, 32);
                const float ainter = fexp(inter - mt);
                const bf16x8 p0 = pack8(st[0], st[1]), p1 = pack8(st[2], st[3]);
                f32x4 qn = {0.f, 0.f, 0.f, 0.f}; qn = mfma16(nf[0], q0, qn); qn = mfma16(nf[1], q1, qn);
                const float qnl = shfl_f(qn[0], fr);
                const float den = ainter * qnl + dsum, rden = frcp(fmaxf(fabsf(den), fexp(-mt)));
#pragma unroll
                for (int et = 0; et < 4; ++et) { f32x4 a = {0.f, 0.f, 0.f, 0.f}; const bf16* cp = cml + it * 4096 + (16 * et + fr) * 64 + 8 * fq;
                    a = mfma16(ldfrag(cp), q0, a); a = mfma16(ldfrag(cp + 32), q1, a); a = a * ainter;
                    a = mfma16(vf[et][0], p0, a); if (lt >= 2) a = mfma16(vf[et][1], p1, a);
                    const int l = dir ? 63 - lp : lp;
#pragma unroll
                    for (int j = 0; j < 4; ++j) { LAS float* hp = hbuf + l * 65 + 16 * et + 4 * fq + j; if (dir == 0) *hp = a[j] * rden; else *hp += a[j] * rden; } }
            }
            wave_sync();
        }
        { const size_t tok = tok0 + lane; float ss = 0.f;
#pragma unroll 16
            for (int e = 0; e < 64; ++e) { const float v = hbuf[lane * 65 + e]; ss += v * v; }
            const float r = frsq(ss * (1.f / 64.f) + EPS);
            const bf16* op = mlb + tok * MLB_LD + 768 + h * 64; bf16* yp = xy + tok * D + 384 + h * 64;
#pragma unroll 2
            for (int e8 = 0; e8 < 8; ++e8) { const u32x4 ow = ld16(op + 8 * e8); const u32 owv[4] = {ow.x, ow.y, ow.z, ow.w}; u32 res[4];
#pragma unroll
                for (int j = 0; j < 4; ++j) { const int e = 8 * e8 + 2 * j; const float y0 = hbuf[lane * 65 + e] * r * norm_w[h * 64 + e] * sigmoidf_(bflo(owv[j])), y1 = hbuf[lane * 65 + e + 1] * r * norm_w[h * 64 + e + 1] * sigmoidf_(bfhi(owv[j])); res[j] = pk2(y0, y1); }
                u32x4 o; o.x = res[0]; o.y = res[1]; o.z = res[2]; o.w = res[3]; *(u32x4*)(yp + 8 * e8) = o; }
            wave_sync(); }
    }
}
static_assert((NC & (NC - 1)) == 0, "NC power of two");
DEV size_t gd_blk(int b, int h, int chunk) { const int bh = b * 6 + h; return (size_t)bh * NC + ((chunk + 11 * bh) & (NC - 1)); }
DEV size_t gd_slot(int b, int h, int dir, int n) { const int c = (b * 6 + h) * 2 + dir; return (size_t)c * NC + ((n + 11 * c) & (NC - 1)); }
DEV void phase_gd_conv(const bf16* __restrict__ gdb, const float* __restrict__ conv_w  , bf16* __restrict__ xy  , bf16* __restrict__ kn, bf16* __restrict__ knt, bf16* __restrict__ vnt,
                       LAS bf16* tl_  , int gw, int NGW, int lane) {
    const int tl = lane >> 3, cg = lane & 7;
    for (int it = gw; it < BATCH * NC * 18; it += NGW) {
        const int sl = it % 18, bc = it / 18, chunk = bc % NC, b = bc / NC, which = sl / 6, h = sl % 6;
        const int ch = which * 384 + h * 64 + cg * 8;
        f32x4 w0[5], w1[5];
#pragma unroll
        for (int dj = 0; dj < 5; ++dj) { w0[dj] = *(const f32x4*)(conv_w + dj * 1152 + ch); w1[dj] = *(const f32x4*)(conv_w + dj * 1152 + ch + 4); }
#pragma unroll 2
        for (int tg = 0; tg < 8; ++tg) {
            const int l = tg * 8 + tl, s = chunk * 64 + l; const size_t tok = (size_t)b * SEQ + s;
            float acc[8];
#pragma unroll
            for (int j = 0; j < 8; ++j) acc[j] = 0.f;
            u32x4 xt[5];
#pragma unroll
            for (int dj = 0; dj < 5; ++dj) { int ss = s + dj - 2; ss = ss < 0 ? 0 : (ss > SEQ - 1 ? SEQ - 1 : ss); xt[dj] = ld16(gdb + ((size_t)b * SEQ + ss) * GDB_LD + ch); }
#pragma unroll
            for (int dj = 0; dj < 5; ++dj) { const int ss = s + dj - 2; const bool ok = (ss >= 0) && (ss < SEQ);
                const u32 xw[4] = {ok ? xt[dj].x : 0u, ok ? xt[dj].y : 0u, ok ? xt[dj].z : 0u, ok ? xt[dj].w : 0u};
                acc[0] += w0[dj][0] * bflo(xw[0]); acc[1] += w0[dj][1] * bfhi(xw[0]); acc[2] += w0[dj][2] * bflo(xw[1]); acc[3] += w0[dj][3] * bfhi(xw[1]);
                acc[4] += w1[dj][0] * bflo(xw[2]); acc[5] += w1[dj][1] * bfhi(xw[2]); acc[6] += w1[dj][2] * bflo(xw[3]); acc[7] += w1[dj][3] * bfhi(xw[3]); }
            float ss2 = 0.f;
#pragma unroll
            for (int j = 0; j < 8; ++j) { acc[j] = acc[j] * sigmoidf_(acc[j]); ss2 += acc[j] * acc[j]; }
            ss2 += shfl_xor_f(ss2, 1); ss2 += shfl_xor_f(ss2, 2); ss2 += shfl_xor_f(ss2, 4);
            if (which < 2) { const float r = frsq(ss2 + EPS);
#pragma unroll
                for (int j = 0; j < 8; ++j) acc[j] *= r; }
            u32x4 o; o.x = pk2(acc[0], acc[1]); o.y = pk2(acc[2], acc[3]); o.z = pk2(acc[4], acc[5]); o.w = pk2(acc[6], acc[7]);
            if (which == 0) *(u32x4*)(xy + tok * D + 640 + h * 64 + cg * 8) = o;
            else { if (which == 1) *(u32x4*)(kn + tok * 384 + h * 64 + cg * 8) = o;
#pragma unroll
                for (int j = 0; j < 8; ++j) tl_[(cg * 8 + j) * 72 + l] = (bf16)f2bf(acc[j]); }
        }
        if (which != 0) { wave_sync();
            bf16* dst = (which == 1 ? knt : vnt) + gd_blk(b, h, chunk) * 4096;
#pragma unroll
            for (int i = 0; i < 8; ++i) { const int u = lane + 64 * i, row = u >> 3, c8 = u & 7;
                *(u32x4*)(dst + row * 64 + c8 * 8) = *(const LAS u32x4*)(tl_ + row * 72 + c8 * 8); }
            wave_sync(); }
    }
}
DEV int gd_item(int b, int h, int dir, int n) { return ((b * 6 + h) * 2 + dir) * NC + n; }
DEV u32x2 ldrow4_raw(const bf16* row, int p0, int dir) { return ld8(row + (dir ? 60 - p0 : p0)); }
DEV u32x2 fixrow4(u32x2 v, int dir) { const u32x2 r = rev4(v); u32x2 o; o.x = dir ? r.x : v.x; o.y = dir ? r.y : v.y; return o; }
DEV u32x2 ldrow4(const bf16* row, int p0, int dir) { const u32x2 v = ld8(row + (dir ? 60 - p0 : p0)); const u32x2 r = rev4(v); u32x2 o; o.x = dir ? r.x : v.x; o.y = dir ? r.y : v.y; return o; }
DEV void phase_gd_prep(const bf16* xy  , const bf16* kn, const bf16* knt, const bf16* vnt, const float* gates, const float* a_log, const float* dt_bias,
                       bf16* gdb  , bf16* wf, bf16* attf, float* gst, LAS float* Al  , LAS float* wsm, int gw, int NGW, int lane0) {
    for (int it = gw; it < NITEM_GD; it += NGW) {
        int ln_ = lane0;
#ifndef EMU
        asm volatile("" : "+v"(ln_));
#endif
        const int lane = ln_, fr = lane & 15, fq = lane >> 4;
        const int dir = it & 1, chunk = (it >> 1) % NC, bh = it / (2 * NC), h = bh % 6, b = bh / 6, n = dir ? NC - 1 - chunk : chunk;
        const size_t tok0 = (size_t)b * SEQ + chunk * 64; const size_t blk = gd_blk(b, h, chunk) * 4096; const size_t slot = gd_slot(b, h, dir, n);
        { const size_t tok = tok0 + (dir ? 63 - lane : lane);
          const float alpha = gates[tok * GATES_LD + 28 + dir * 6 + h], bpre = gates[tok * GATES_LD + 16 + dir * 6 + h];
          const float g = -expf(a_log[dir * 6 + h]) * softplusf_(alpha + dt_bias[dir * 6 + h]), beta = sigmoidf_(bpre);
          const float gc = wave_incl_scan(g, lane), gl = lane63_f(gc);
          wave_sync(); wsm[lane] = gc; wsm[64 + lane] = beta; wsm[128 + lane] = beta * expf(gc); wave_sync();
          float* gs = gst + slot * 192; gs[lane] = 0.125f * expf(gc); gs[64 + lane] = expf(gl - gc); if (lane == 0) gs[128] = expf(gl); }
        bf16x8 kr[4][2];
        bf16* attp = attf + slot * 4096;
        bf16x8 qn0, qn1, kn0, kn1;
        { const int lp0 = fr; const bf16* qrow = xy + (tok0 + (dir ? 63 - lp0 : lp0)) * D + 640 + h * 64 + 8 * fq; qn0 = ldfrag(qrow); qn1 = ldfrag(qrow + 32);
          const bf16* krow = kn + (tok0 + (dir ? 63 - lp0 : lp0)) * 384 + h * 64 + 8 * fq; kn0 = ldfrag(krow); kn1 = ldfrag(krow + 32); }
#define GD_GROUP(LT) { const int lp = 16 * (LT) + fr; const float gcl = wsm[lp], bel = wsm[64 + lp]; \
            const bf16x8 q0 = qn0, q1 = qn1, kl0 = kn0, kl1 = kn1; kr[(LT)][0] = kl0; kr[(LT)][1] = kl1; \
            if ((LT) < 3) { const int lpn = 16 * ((LT) + 1) + fr; const bf16* qrow = xy + (tok0 + (dir ? 63 - lpn : lpn)) * D + 640 + h * 64 + 8 * fq; qn0 = ldfrag(qrow); qn1 = ldfrag(qrow + 32); \
              const bf16* krow = kn + (tok0 + (dir ? 63 - lpn : lpn)) * 384 + h * 64 + 8 * fq; kn0 = ldfrag(krow); kn1 = ldfrag(krow + 32); } \
            f32x4 at[4]; \
            _Pragma("unroll") for (int s4 = 0; s4 < 4; ++s4) { \
                if (s4 <= (LT)) { f32x4 x = {0.f, 0.f, 0.f, 0.f}; x = mfma16(kr[s4][0], kl0, x); x = mfma16(kr[s4][1], kl1, x); \
                    f32x4 y = {0.f, 0.f, 0.f, 0.f}; y = mfma16(kr[s4][0], q0, y); y = mfma16(kr[s4][1], q1, y); f32x4 av; \
                    const f32x4 gcs_ = *(const LAS f32x4*)(wsm + 16 * s4 + 4 * fq); \
                    _Pragma("unroll") for (int j = 0; j < 4; ++j) { float dec = fexp(gcl - gcs_[j]); float da = dec; \
                        if (s4 == (LT)) { dec = (4 * fq + j <= fr) ? dec : 0.f; da = (4 * fq + j < fr) ? da : 0.f; } \
                        av[j] = bel * x[j] * da; y[j] = y[j] * 0.125f * dec; } \
                    *(LAS f32x4*)(Al + lp * 64 + 16 * s4 + 4 * fq) = av; at[s4] = y; } \
                } \
            { u32 z0_ = 0u; LAUNDER_V(z0_); u32x4 f0 = {z0_, z0_, z0_, z0_}, f1 = f0;                  \
              f0.x = pk2(at[0][0], at[0][1]); f0.y = pk2(at[0][2], at[0][3]); if ((LT) >= 1) { f0.z = pk2(at[1][0], at[1][1]); f0.w = pk2(at[1][2], at[1][3]); } \
              if ((LT) >= 2) { f1.x = pk2(at[2][0], at[2][1]); f1.y = pk2(at[2][2], at[2][3]); } if ((LT) >= 3) { f1.z = pk2(at[3][0], at[3][1]); f1.w = pk2(at[3][2], at[3][3]); } \
              *(u32x4*)(attp + (((LT) * 2 + 0) * 64 + lane) * 8) = f0; *(u32x4*)(attp + (((LT) * 2 + 1) * 64 + lane) * 8) = f1; } SCHED_FENCE(); }
        GD_GROUP(0) GD_GROUP(1) GD_GROUP(2) GD_GROUP(3)
#undef GD_GROUP
        u32x4 vl[8];
#pragma unroll
        for (int i = 0; i < 8; ++i) vl[i] = ld16(vnt + blk + (size_t)(lane + 64 * i) * 8);
        wave_sync();
        float t[64];
#pragma unroll
        for (int i = 0; i < 64; ++i) {
            float a[4] = {(i == lane) ? 1.f : 0.f, 0.f, 0.f, 0.f};
#pragma unroll
            for (int hb_ = 0; hb_ < (i + 31) / 32; ++hb_) { f32x4 row[8]; const int nch = (i - 32 * hb_ + 3) / 4 > 8 ? 8 : (i - 32 * hb_ + 3) / 4;
#pragma unroll
                for (int j4 = 0; j4 < nch; ++j4) row[j4] = *(const LAS f32x4*)(Al + i * 64 + 32 * hb_ + 4 * j4);
                SCHED_FENCE();
#pragma unroll
                for (int j4 = 0; j4 < nch; ++j4)
#pragma unroll
                    for (int j = 0; j < 4; ++j) if (32 * hb_ + 4 * j4 + j < i) a[j] -= row[j4][j] * t[32 * hb_ + 4 * j4 + j];
                SCHED_FENCE(); }
            t[i] = (a[0] + a[1]) + (a[2] + a[3]); }
        wave_sync();
        LAS bf16* Tl = (LAS bf16*)Al;
#pragma unroll
        for (int i = 0; i < 64; ++i) Tl[i * 64 + lane] = (bf16)f2bf(t[i]);
        wave_sync();
        bf16x8 tf[4][2];
#pragma unroll
        for (int lt = 0; lt < 4; ++lt)
#pragma unroll
            for (int sb = 0; sb < 2; ++sb) { const LAS bf16* tr = Tl + (16 * lt + fr) * 64 + 32 * sb + 4 * fq; tf[lt][sb] = frag2(*(const LAS u32x2*)tr, *(const LAS u32x2*)(tr + 16)); }
        LAS unsigned char* Bl = (LAS unsigned char*)Al + 8192;
#pragma unroll
        for (int i = 0; i < 8; ++i) { const int u = lane + 64 * i, r = u >> 3; *(LAS u32x4*)(Bl + r * 128 + (((u & 7) ^ (r & 7)) << 4)) = vl[i]; }
        u32x4 kl[8];
#pragma unroll
        for (int i = 0; i < 8; ++i) kl[i] = ld16(knt + blk + (size_t)(lane + 64 * i) * 8);
        wave_sync();
#define BL_ROW4(r, p0) (*(const LAS u32x2*)(Bl + (r) * 128 + (((((dir ? 60 - (p0) : (p0)) >> 3)) ^ ((r) & 7)) << 4) + (((dir ? 60 - (p0) : (p0)) & 7) << 1)))
        const int ucol = dir ? 384 : 0;
#pragma unroll
        for (int et = 0; et < 4; ++et) { bf16x8 vb[2];
#pragma unroll
            for (int sb = 0; sb < 2; ++sb) { const int s0 = 32 * sb + 4 * fq, s1 = s0 + 16, re = 16 * et + fr; const u32x2 a = fixrow4(BL_ROW4(re, s0), dir), c = fixrow4(BL_ROW4(re, s1), dir); u32x4 w;
                w.x = pk2(bflo(a.x) * wsm[64 + s0], bfhi(a.x) * wsm[64 + s0 + 1]); w.y = pk2(bflo(a.y) * wsm[64 + s0 + 2], bfhi(a.y) * wsm[64 + s0 + 3]);
                w.z = pk2(bflo(c.x) * wsm[64 + s1], bfhi(c.x) * wsm[64 + s1 + 1]); w.w = pk2(bflo(c.y) * wsm[64 + s1 + 2], bfhi(c.y) * wsm[64 + s1 + 3]); vb[sb] = __builtin_bit_cast(bf16x8, w); }
#pragma unroll
            for (int lt = 0; lt < 4; ++lt) { f32x4 u = {0.f, 0.f, 0.f, 0.f}; u = mfma16(tf[lt][0], vb[0], u); u = mfma16(tf[lt][1], vb[1], u);
                u32x2 w; w.x = pk2(u[0], u[1]); w.y = pk2(u[2], u[3]);
                *(u32x2*)(gdb + (tok0 + 16 * et + fr) * GDB_LD + ucol + h * 64 + 16 * lt + 4 * fq) = w; } }
        bf16* wp = wf + slot * 4096;
        wave_sync();
#pragma unroll
        for (int i = 0; i < 8; ++i) { const int u = lane + 64 * i, r = u >> 3; *(LAS u32x4*)(Bl + r * 128 + (((u & 7) ^ (r & 7)) << 4)) = kl[i]; }
        wave_sync();
#pragma unroll
        for (int db = 0; db < 2; ++db) { f32x4 wa[2][4];
#pragma unroll
            for (int d2 = 0; d2 < 2; ++d2) { const int dt = 2 * db + d2; bf16x8 kb[2];
#pragma unroll
                for (int sb = 0; sb < 2; ++sb) { const int s0 = 32 * sb + 4 * fq, s1 = s0 + 16, rd = 16 * dt + fr; const u32x2 a = fixrow4(BL_ROW4(rd, s0), dir), c = fixrow4(BL_ROW4(rd, s1), dir); u32x4 w;
                    w.x = pk2(bflo(a.x) * wsm[128 + s0], bfhi(a.x) * wsm[128 + s0 + 1]); w.y = pk2(bflo(a.y) * wsm[128 + s0 + 2], bfhi(a.y) * wsm[128 + s0 + 3]);
                    w.z = pk2(bflo(c.x) * wsm[128 + s1], bfhi(c.x) * wsm[128 + s1 + 1]); w.w = pk2(bflo(c.y) * wsm[128 + s1 + 2], bfhi(c.y) * wsm[128 + s1 + 3]); kb[sb] = __builtin_bit_cast(bf16x8, w); }
#pragma unroll
                for (int lt = 0; lt < 4; ++lt) { f32x4 x = {0.f, 0.f, 0.f, 0.f}; x = mfma16(kb[0], tf[lt][0], x); x = mfma16(kb[1], tf[lt][1], x); wa[d2][lt] = -x; } }
#pragma unroll
            for (int lt = 0; lt < 4; ++lt) *(u32x4*)(wp + ((lt * 2 + db) * 64 + lane) * 8) = __builtin_bit_cast(u32x4, pack8(wa[0][lt], wa[1][lt])); }
        wave_sync();
#undef BL_ROW4
    }
}
constexpr int RS_P = 144;
constexpr int RS_W = 0, RS_ATT = 8192, RS_U = 16384, RS_Q = RS_U + 64 * RS_P, RS_KT = RS_Q + 64 * RS_P, RS_ST = RS_KT + 64 * RS_P, RS_BYTES = RS_ST + 1024;
static_assert(2 * RS_BYTES <= RING_BYTES, "recurrence stages");
struct GdLoad { u32x4 w[2], a[2], u[2], q[2], k[2], s; };
DEV void gd_issue(GdLoad& L, const bf16* xy, const bf16* knt, const bf16* gdb, const bf16* wf, const bf16* attf, const float* gst, int b, int h, int dir, int n, int lt_) {
    const int chunk = dir ? NC - 1 - n : n; const size_t it = gd_slot(b, h, dir, n); const size_t tok0 = (size_t)b * SEQ + chunk * 64; const size_t blk = gd_blk(b, h, chunk) * 4096;
#pragma unroll
    for (int i = 0; i < 2; ++i) { const int u = lt_ + 256 * i;
        L.w[i] = ld16(wf + it * 4096 + u * 8); L.a[i] = ld16(attf + it * 4096 + u * 8);
        const int row = u >> 3, c8 = u & 7;
        L.u[i] = ld16(gdb + (tok0 + row) * GDB_LD + (dir ? 384 : 0) + h * 64 + c8 * 8);
        L.q[i] = ld16(xy + (tok0 + (dir ? 63 - row : row)) * D + 640 + h * 64 + c8 * 8);
        L.k[i] = ld16(knt + blk + (size_t)row * 64 + (dir ? 7 - c8 : c8) * 8); }
    L.s = ld16(gst + it * 192 + (lt_ < 48 ? lt_ : 47) * 4);
}
DEV void gd_commit(const GdLoad& L, LAS unsigned char* st, int lt_, int dir) {
#pragma unroll
    for (int i = 0; i < 2; ++i) { const int u = lt_ + 256 * i;
        *(LAS u32x4*)(st + RS_W + u * 16) = L.w[i]; *(LAS u32x4*)(st + RS_ATT + u * 16) = L.a[i]; const int po = (u >> 3) * RS_P + (u & 7) * 16; *(LAS u32x4*)(st + RS_U + po) = L.u[i];
        *(LAS u32x4*)(st + RS_Q + po) = L.q[i]; const u32x4 kr_ = rev8(L.k[i]); u32x4 kk; kk.x = dir ? kr_.x : L.k[i].x; kk.y = dir ? kr_.y : L.k[i].y; kk.z = dir ? kr_.z : L.k[i].z; kk.w = dir ? kr_.w : L.k[i].w; *(LAS u32x4*)(st + RS_KT + po) = kk; }
    if (lt_ < 48) *(LAS u32x4*)(st + RS_ST + lt_ * 16) = L.s;
}
DEV void gd_step(f32x4 (&S)[4], const LAS unsigned char* st, bf16* gdb, bf16* obw, int b, int h, int dir, int n, int es, int lane) {
    const int fr = lane & 15, fq = lane >> 4;
    const int chunk = dir ? NC - 1 - n : n; const size_t tok0 = (size_t)b * SEQ + chunk * 64;
    const LAS float* stf = (const LAS float*)(st + RS_ST);
    bf16x8 wfr[4][2], afr[4][2], qfr[4][2], kfr[4][2]; u32x2 uw[4]; f32x4 eq[4], ek[4];
#pragma unroll
    for (int lt = 0; lt < 4; ++lt) { uw[lt] = *(const LAS u32x2*)(st + RS_U + (16 * es + fr) * RS_P + (16 * lt + 4 * fq) * 2);
        wfr[lt][0] = *(const LAS bf16x8*)(st + RS_W + ((lt * 2 + 0) * 64 + lane) * 16); wfr[lt][1] = *(const LAS bf16x8*)(st + RS_W + ((lt * 2 + 1) * 64 + lane) * 16);
        const LAS bf16* qr = (const LAS bf16*)(st + RS_Q + (16 * lt + fr) * RS_P) + 4 * fq;
        qfr[lt][0] = frag2(*(const LAS u32x2*)qr, *(const LAS u32x2*)(qr + 16)); qfr[lt][1] = frag2(*(const LAS u32x2*)(qr + 32), *(const LAS u32x2*)(qr + 48));
        eq[lt] = *(const LAS f32x4*)(stf + 16 * lt + 4 * fq); }
    const float egl = stf[128];
#pragma unroll
    for (int lt = 0; lt < 4; ++lt) { afr[lt][0] = *(const LAS bf16x8*)(st + RS_ATT + ((lt * 2 + 0) * 64 + lane) * 16); afr[lt][1] = *(const LAS bf16x8*)(st + RS_ATT + ((lt * 2 + 1) * 64 + lane) * 16);
        ek[lt] = *(const LAS f32x4*)(stf + 64 + 16 * lt + 4 * fq); }
    SCHED_FENCE();
    const bf16x8 sb0 = pack8(S[0], S[1]), sb1 = pack8(S[2], S[3]);
    f32x4 vn[4], o[4];
#pragma unroll
    for (int lt = 0; lt < 4; ++lt) {
        f32x4 v = {bflo(uw[lt].x), bfhi(uw[lt].x), bflo(uw[lt].y), bfhi(uw[lt].y)};
        v = mfma16(wfr[lt][0], sb0, v); v = mfma16(wfr[lt][1], sb1, v); vn[lt] = v;
        f32x4 x = {0.f, 0.f, 0.f, 0.f}; x = mfma16(qfr[lt][0], sb0, x); x = mfma16(qfr[lt][1], sb1, x); o[lt] = x * eq[lt]; }
#pragma unroll
    for (int lt = 0; lt < 4; ++lt) { const LAS bf16* kr = (const LAS bf16*)(st + RS_KT + (16 * lt + fr) * RS_P) + 4 * fq;
        kfr[lt][0] = frag2(*(const LAS u32x2*)kr, *(const LAS u32x2*)(kr + 16)); kfr[lt][1] = frag2(*(const LAS u32x2*)(kr + 32), *(const LAS u32x2*)(kr + 48)); }
    const bf16x8 vb0 = pack8(vn[0], vn[1]), vb1 = pack8(vn[2], vn[3]);
#pragma unroll
    for (int lt = 0; lt < 4; ++lt) {
        f32x4 x = o[lt]; x = mfma16(afr[lt][0], vb0, x); x = mfma16(afr[lt][1], vb1, x);
        u32x2 w; w.x = pk2(x[0], x[1]); w.y = pk2(x[2], x[3]);
        if (dir == 0) *(u32x2*)(gdb + (tok0 + 16 * es + fr) * GDB_LD + 768 + h * 64 + 16 * lt + 4 * fq) = w;
        else *(u32x2*)(obw + gd_blk(b, h, chunk) * 4096 + (16 * es + fr) * 64 + 16 * lt + 4 * fq) = w;
        vn[lt] = vn[lt] * ek[lt]; }
    const bf16x8 vs0 = pack8(vn[0], vn[1]), vs1 = pack8(vn[2], vn[3]);
#pragma unroll
    for (int dt = 0; dt < 4; ++dt) { f32x4 x = S[dt] * egl; x = mfma16(kfr[dt][0], vs0, x); x = mfma16(kfr[dt][1], vs1, x); S[dt] = x; }
}
DEV void phase_gd_recur(const bf16* xy, const bf16* knt, bf16* gdb, const bf16* wf, const bf16* attf, const float* gst, bf16* obw, LAS unsigned char* lds, int bid, int G, int tid) {
    const int wave = rfl(tid >> 6), lane = tid & 63; const bool loader = wave >= 4; const int lt_ = tid - 256;
    static_assert(NC >= 4, "recurrence pipeline");
    for (int chain = bid; chain < BATCH * 6 * 2; chain += G) {
        const int dir = chain & 1, bh = chain >> 1, h = bh % 6, b = bh / 6;
        if (loader) {
            GdLoad L0, L1, L2;
            gd_issue(L0, xy, knt, gdb, wf, attf, gst, b, h, dir, 0, lt_); gd_commit(L0, lds, lt_, dir);
            gd_issue(L1, xy, knt, gdb, wf, attf, gst, b, h, dir, 1, lt_); gd_issue(L2, xy, knt, gdb, wf, attf, gst, b, h, dir, 2, lt_); gd_issue(L0, xy, knt, gdb, wf, attf, gst, b, h, dir, 3, lt_);
            lds_barrier();
#define GD_SUB(k, SET) { gd_commit(SET, lds + (((k) + 1) & 1) * RS_BYTES, lt_, dir); { const int s4_ = n + (k) + 4; gd_issue(SET, xy, knt, gdb, wf, attf, gst, b, h, dir, s4_ < NC ? s4_ : NC - 1, lt_); } lds_barrier(); }
            int n = 0;
#pragma unroll 1
            for (; n + 6 <= NC; n += 6) { GD_SUB(0, L1) GD_SUB(1, L2) GD_SUB(2, L0) GD_SUB(3, L1) GD_SUB(4, L2) GD_SUB(5, L0) }
            if constexpr (NC % 6 >= 1) GD_SUB(0, L1)
            if constexpr (NC % 6 >= 2) GD_SUB(1, L2)
            if constexpr (NC % 6 >= 3) GD_SUB(2, L0)
            if constexpr (NC % 6 >= 4) GD_SUB(3, L1)
            if constexpr (NC % 6 >= 5) GD_SUB(4, L2)
#undef GD_SUB
        } else {
            f32x4 S[4];
#pragma unroll
            for (int dt = 0; dt < 4; ++dt) S[dt] = (f32x4){0.f, 0.f, 0.f, 0.f};
            lds_barrier();
#pragma unroll 1
            for (int n = 0; n < NC; ++n) { gd_step(S, lds + (n & 1) * RS_BYTES, gdb, obw, b, h, dir, n, wave, lane); lds_barrier(); }
        }
    }
}
DEV void phase_gd_final(const bf16* __restrict__ gdb, const bf16* __restrict__ obw, const float* __restrict__ norm_w, bf16* __restrict__ xy, LAS float* hb  , int gw, int NGW, int lane) {
    const int er = lane >> 3, c8 = lane & 7;
    for (int wi = gw; wi < BATCH * NC * 6; wi += NGW) {
        const int h = wi % 6, bc = wi / 6, chunk = bc % NC, b = bc / NC; const size_t tok0 = (size_t)b * SEQ + chunk * 64, tok = tok0 + lane;
        const bf16* ob = obw + gd_blk(b, h, chunk) * 4096;
        u32x4 f[8], g[8], zv[8];
#pragma unroll
        for (int i = 0; i < 8; ++i) { const int e = er + 8 * i; f[i] = ld16(gdb + (tok0 + e) * GDB_LD + 768 + h * 64 + c8 * 8); g[i] = ld16(ob + e * 64 + (7 - c8) * 8); }
#pragma unroll
        for (int e8 = 0; e8 < 8; ++e8) zv[e8] = ld16(gdb + tok * GDB_LD + 1152 + h * 64 + 8 * e8);
#pragma unroll
        for (int i = 0; i < 8; ++i) { const int e = er + 8 * i; const u32x4 gr = rev8(g[i]); const u32 fw[4] = {f[i].x, f[i].y, f[i].z, f[i].w}, gw_[4] = {gr.x, gr.y, gr.z, gr.w};
#pragma unroll
            for (int j = 0; j < 4; ++j) { hb[(8 * c8 + 2 * j) * 65 + e] = bflo(fw[j]) + bflo(gw_[j]); hb[(8 * c8 + 2 * j + 1) * 65 + e] = bfhi(fw[j]) + bfhi(gw_[j]); } }
        wave_sync();
        float ss = 0.f;
#pragma unroll 16
        for (int e = 0; e < 64; ++e) { const float v = hb[lane * 65 + e]; ss += v * v; }
        const float r = frsq(ss * (1.f / 64.f) + EPS);
#pragma unroll
        for (int e8 = 0; e8 < 8; ++e8) { const u32 zw[4] = {zv[e8].x, zv[e8].y, zv[e8].z, zv[e8].w}; u32 res[4];
#pragma unroll
            for (int j = 0; j < 4; ++j) { const int e = 8 * e8 + 2 * j; const float z0 = bflo(zw[j]), z1 = bfhi(zw[j]);
                res[j] = pk2(hb[lane * 65 + e] * r * norm_w[h * 64 + e] * z0 * sigmoidf_(z0), hb[lane * 65 + e + 1] * r * norm_w[h * 64 + e + 1] * z1 * sigmoidf_(z1)); }
            u32x4 o; o.x = res[0]; o.y = res[1]; o.z = res[2]; o.w = res[3]; *(u32x4*)(xy + tok * D + 640 + h * 64 + 8 * e8) = o; }
        wave_sync();
    }
}
constexpr int XA_PITCH = 528;
static_assert(256 * XA_PITCH <= MISC_OFF, "cross-attention LDS image");
DEV void xa_stage(const bf16* base, size_t pitch_el, LAS unsigned char* lds, int tid) {
#pragma unroll 1
    for (int hf = 0; hf < 2; ++hf) { u32x4 r[8];
#pragma unroll
        for (int i = 0; i < 8; ++i) { const int idx = tid + 512 * (8 * hf + i); r[i] = ld16(base + (size_t)(idx >> 5) * pitch_el + (idx & 31) * 8); }
#pragma unroll
        for (int i = 0; i < 8; ++i) { const int idx = tid + 512 * (8 * hf + i); *(LAS u32x4*)(lds + (idx >> 5) * XA_PITCH + (idx & 31) * 16) = r[i]; } }
}
DEV void phase_xattn(const bf16* __restrict__ qx, const bf16* __restrict__ kx  , const bf16* __restrict__ vtx  , bf16* __restrict__ out, LAS unsigned char* lds, int bid, int G, int tid) {
    const int wave = rfl(tid >> 6), lane = tid & 63, fr = lane & 15, fq = lane >> 4;
    constexpr int NU = (T / 256) * 4;
    for (int un = bid; un < NU; un += G) {
        const int hx = un & 3, qb = un >> 2; const size_t row0 = (size_t)qb * 256 + wave * 32; const int b = (int)(((size_t)qb * 256) / SEQ);
        xa_stage(kx + (size_t)b * NMEM * D + hx * 256, D, lds, tid);
        const bf16* qrow0 = qx + (row0 + fr) * D + hx * 256 + 8 * fq; const bf16* qrow1 = qrow0 + (size_t)16 * D;
        bf16x8 qn0 = ldfrag(qrow0), qn1 = ldfrag(qrow1);
        __syncthreads();
        f32x4 sacc[16][2];
#pragma unroll
        for (int mt = 0; mt < 16; ++mt) { sacc[mt][0] = (f32x4){0.f, 0.f, 0.f, 0.f}; sacc[mt][1] = (f32x4){0.f, 0.f, 0.f, 0.f}; }
#pragma unroll 1
        for (int kb = 0; kb < 8; ++kb) { const bf16x8 q0 = qn0, q1 = qn1; if (kb < 7) { qn0 = ldfrag(qrow0 + 32 * (kb + 1)); qn1 = ldfrag(qrow1 + 32 * (kb + 1)); }
            const LAS unsigned char* kr = lds + fr * XA_PITCH + 16 * fq + 64 * kb;
#pragma unroll
            for (int mt = 0; mt < 16; ++mt) { const bf16x8 kf = *(const LAS bf16x8*)(kr + 16 * mt * XA_PITCH); sacc[mt][0] = mfma16(kf, q0, sacc[mt][0]); sacc[mt][1] = mfma16(kf, q1, sacc[mt][1]); } }
        float inv[2]; bf16x8 pf[8][2];
#pragma unroll
        for (int qt = 0; qt < 2; ++qt) { float mx = -1e30f;
#pragma unroll
            for (int mt = 0; mt < 16; ++mt)
#pragma unroll
                for (int j = 0; j < 4; ++j) mx = fmaxf(mx, sacc[mt][qt][j]);
            mx = fmaxf(mx, shfl_xor_f(mx, 16)); mx = fmaxf(mx, shfl_xor_f(mx, 32));
            float sum = 0.f;
#pragma unroll
            for (int mt = 0; mt < 16; ++mt)
#pragma unroll
                for (int j = 0; j < 4; ++j) { const float p = fexp((sacc[mt][qt][j] - mx) * 0.0625f); sacc[mt][qt][j] = p; sum += p; }
            sum += shfl_xor_f(sum, 16); sum += shfl_xor_f(sum, 32); inv[qt] = frcp(sum);
#pragma unroll
            for (int mb = 0; mb < 8; ++mb) pf[mb][qt] = pack8(sacc[2 * mb][qt], sacc[2 * mb + 1][qt]); }
        __syncthreads();
        xa_stage(vtx + (size_t)(hx * 256) * NMEMROWS + (size_t)b * NMEM, NMEMROWS, lds, tid);
        __syncthreads();
#pragma unroll 2
        for (int d16 = 0; d16 < 16; ++d16) { f32x4 o0 = {0.f, 0.f, 0.f, 0.f}, o1 = {0.f, 0.f, 0.f, 0.f}; const LAS unsigned char* vr = lds + (16 * d16 + fr) * XA_PITCH + 8 * fq;
#pragma unroll
            for (int mb = 0; mb < 8; ++mb) { const bf16x8 vf = frag2(*(const LAS u32x2*)(vr + 64 * mb), *(const LAS u32x2*)(vr + 64 * mb + 32)); o0 = mfma16(vf, pf[mb][0], o0); o1 = mfma16(vf, pf[mb][1], o1); }
            { const f32x4 x = o0 * inv[0]; u32x2 w; w.x = pk2(x[0], x[1]); w.y = pk2(x[2], x[3]); *(u32x2*)(out + (row0 + fr) * D + hx * 256 + 16 * d16 + 4 * fq) = w; }
            { const f32x4 x = o1 * inv[1]; u32x2 w; w.x = pk2(x[0], x[1]); w.y = pk2(x[2], x[3]); *(u32x2*)(out + (row0 + 16 + fr) * D + hx * 256 + 16 * d16 + 4 * fq) = w; } }
        __syncthreads();
    }
}
#ifndef MK_SPLIT
#define MK_SPLIT 0
#endif
constexpr int NPL = 14, NPHASE = 2 + DEPTH * NPL;
constexpr int NCHAIN_GD = BATCH * 6 * 2;
struct Args { const float* in[22]; float* out; unsigned char* ws; int ph_lo, ph_hi; };
__global__ void __launch_bounds__(NWAVES * 64, 2) fwd_kernel(Args args) {
#ifndef EMU
    extern __shared__ __attribute__((aligned(16))) unsigned char lds_raw[];
    LAS unsigned char* lds = (LAS unsigned char*)lds_raw;
#else
    unsigned char* lds = emu_lds();
#endif
    const int bid = blockIdx.x, G = gridDim.x, NGW = G * NWAVES;
    const int wave_s = rfl((int)threadIdx.x >> 6);
#ifndef EMU
    { const int t0 = threadIdx.x;
      for (int u = t0; u < (LDS_BYTES - MISC_OFF) / 4; u += NWAVES * 64) ((LAS unsigned*)(lds + MISC_OFF))[u] = 0u; }
    __syncthreads();
    XcdBarrier bar; bar.wv = wave_s; bar.bar = (unsigned*)(args.ws + WS_CTL) + CW_BAR; bar.x = 0; bar.st = nullptr;
    if (!MK_SPLIT) bar = xcd_barrier_post((unsigned*)(args.ws + WS_CTL) + CW_BAR, (volatile LAS unsigned*)(lds + MISC_OFF) + 8);
#define GRID_BAR() do { if (!MK_SPLIT) xcd_barrier(bar); } while (0)
#define SUB_BAR(key, n) sub_barrier((unsigned*)(args.ws + WS_CTL) + 8192 + 64 * (key), (unsigned)(n), (unsigned*)(args.ws + WS_CTL) + CW_BAR + XB_TMO, wave_s == 0 && lane_id() == 0)
#define PH_LOCALS() int z_ = 0; asm volatile("" : "+s"(z_)); int tid = wave_s * 64 + lane_id(); asm volatile("" : "+v"(tid)); \
    const int lane = tid & 63, wave = rfl(tid >> 6), gw = bid * NWAVES + wave; unsigned char* ws = args.ws + z_; float* xo = args.out + z_; unsigned char* pro = PRO_IN_OUT ? (unsigned char*)xo : ws; (void)pro; unsigned char* absb = ABS_IN_OUT ? (unsigned char*)xo : ws; (void)absb; \
    LAS float* wscr = (LAS float*)(lds + wave * WSCR_BYTES); LAS float* wsm = (LAS float*)(lds + WSM_OFF + wave * 1024); \
    bf16* XY = (bf16*)(ws + WS_XY); bf16* YB = (bf16*)xo; bf16* NAB = (bf16*)(ws + WS_NAB); bf16* MLB = (bf16*)(ws + WS_MLB); bf16* GDB = (bf16*)(ws + WS_GDB); float* GATES = (float*)(ws + WS_GATES); \
    (void)YB; (void)lane; (void)gw; (void)xo; (void)wscr; (void)wsm; (void)XY; (void)NAB; (void)MLB; (void)GDB; (void)GATES;
#define AIN(k) (args.in[(k) + z_])
#else
#define GRID_BAR() emu_grid_sync()
#define SUB_BAR(key, n) emu_sub_sync((key), (int)(n) * 512)
#define PH_LOCALS() int z_ = 0; int tid = wave_s * 64 + lane_id(); \
    const int lane = tid & 63, wave = rfl(tid >> 6), gw = bid * NWAVES + wave; unsigned char* ws = args.ws + z_; float* xo = args.out + z_; unsigned char* pro = PRO_IN_OUT ? (unsigned char*)xo : ws; (void)pro; unsigned char* absb = ABS_IN_OUT ? (unsigned char*)xo : ws; (void)absb; \
    LAS float* wscr = (LAS float*)(lds + wave * WSCR_BYTES); LAS float* wsm = (LAS float*)(lds + WSM_OFF + wave * 1024); \
    bf16* XY = (bf16*)(ws + WS_XY); bf16* YB = (bf16*)xo; bf16* NAB = (bf16*)(ws + WS_NAB); bf16* MLB = (bf16*)(ws + WS_MLB); bf16* GDB = (bf16*)(ws + WS_GDB); float* GATES = (float*)(ws + WS_GATES); \
    (void)YB; (void)lane; (void)gw; (void)xo; (void)wscr; (void)wsm; (void)XY; (void)NAB; (void)MLB; (void)GDB; (void)GATES;
#define AIN(k) (args.in[(k) + z_])
#endif
    const int lo = args.ph_lo, hi = args.ph_hi;
#define IN(k) (lo <= (k) && (k) < hi)
#define SEAM(k) do { if (IN((k) + 1)) GRID_BAR(); } while (0)
#define SEAM2(k) do { if (IN((k) + 2)) GRID_BAR(); } while (0)

    if (IN(0)) { PH_LOCALS();
        P0Args a{AIN(3), AIN(12), AIN(15), AIN(16), AIN(17), AIN(19), AIN(20), AIN(0), AIN(1), AIN(2), AIN(14), AIN(13), AIN(18)};
        phase_prologue(a, ws, pro, wscr, gw, NGW, lane);
        SEAM2(0);
    }
#define KV_GEMMS(Gv, cv) do { for (int i = 0; i < DEPTH; ++i) { \
            const bf16* memn = (const bf16*)(pro + PRO_MEMN) + (size_t)i * NMEMROWS * D; const bf16* wkv = (const bf16*)(pro + PRO_WXKV) + (size_t)i * 2048 * D; \
            pg8::Gemm g{memn, wkv, NMEMROWS, 2048, D}; \
            pg8::EpiBf16<0, 2> E{(bf16*)(ws + WS_KX) + (size_t)i * NMEMROWS * D, 256, nullptr, (bf16*)(ws + WS_VTX) + (size_t)i * NMEMROWS * D, (LAS unsigned char*)(lds + STG_OFF)}; \
            pg8::StaticOrder S; S.init(g.M, g.N, (Gv), ((cv) + (Gv) - ((8 * BATCH * i) % (Gv))) % (Gv)); S.wv = wave_s;     \
            pg8::gemm_phase<pg8::EpiBf16<0, 2>, pg8::StaticOrder, true, true>(lds, g, S, E); } } while (0)
#define ABS_GEMMS(lsel, Gv, cv) do { const int k256 = 256 + z_;     \
        _Pragma("unroll 1") for (int i = 0; i < 2; ++i) { const int l_ = (lsel); \
            if (!(i & 1)) { pg8::Gemm g{(const bf16*)(ws + WS_KX) + (size_t)l_ * NMEMROWS * D, (const bf16*)(ws + WS_WXQ) + (size_t)l_ * D * D, NMEMROWS * 4, D, k256}; \
                pg8::EpiBf16<0> E{(bf16*)(absb + ABS_MT) + (size_t)l_ * BATCH * D * D, D, nullptr, nullptr, (LAS unsigned char*)(lds + STG_OFF)}; \
                pg8::StaticOrder S; S.init(g.M, g.N, (Gv), ((cv) + (Gv) - ((16 * BATCH * i) % (Gv))) % (Gv)); S.wv = wave_s; S.bmode = 2; \
                pg8::gemm_phase<pg8::EpiBf16<0>, pg8::StaticOrder, true, true>(lds, g, S, E); } \
            else { pg8::Gemm g{(const bf16*)(ws + WS_WXO) + (size_t)l_ * D * D, (const bf16*)(ws + WS_VTX) + (size_t)l_ * NMEMROWS * D, 4 * D, BATCH * 256, k256}; \
                pg8::EpiBf16<0, 1> E{(bf16*)(absb + ABS_NT) + (size_t)l_ * BATCH * D * D, D, nullptr, nullptr, (LAS unsigned char*)(lds + STG_OFF)}; \
                pg8::StaticOrder S; S.init(g.M, g.N, (Gv), ((cv) + (Gv) - ((16 * BATCH * i) % (Gv))) % (Gv)); S.wv = wave_s; S.bmode = 3; \
                pg8::gemm_phase<pg8::EpiBf16<0, 1>, pg8::StaticOrder, true, true>(lds, g, S, E); } } } while (0)
    for (int l = 0; l < DEPTH; ++l) {
        const int pb = 2 + l * NPL;
        if (IN(pb + 0)) { PH_LOCALS();
            pg8::Gemm g{XY, (const bf16*)(ws + WS_WIN) + (size_t)l * NPROJ * D, T, NPROJ, D}; pg8::StaticOrder S; S.init(T, NPROJ, G, bid); S.wv = wave_s;
            pg8::EpiInProj E{NAB, MLB, GDB, GATES, (const float*)(ws + WS_RSS), (LAS unsigned char*)(lds + STG_OFF)};
            pg8::gemm_phase<pg8::EpiInProj, pg8::StaticOrder, true, true>(lds, g, S, E);
            SEAM(pb + 0);
        }
        if (IN(pb + 1)) { PH_LOCALS();
            phase_na2(NAB, AIN(4) + (size_t)l * 6 * 15 * 31, YB, lds, bid, G, tid);
            __syncthreads();
            phase_gd_conv(GDB, AIN(8) + (size_t)l * 5 * 1152, YB, (bf16*)(ws + WS_KN), (bf16*)(ws + WS_KNT), (bf16*)(ws + WS_VNT), (LAS bf16*)(lds + wave * 9216), gw, NGW, lane);
            __syncthreads();
            SEAM(pb + 1);
        }
        if (IN(pb + 2)) { PH_LOCALS();
            phase_ml1(MLB, GATES, AIN(5) + l * 8, AIN(6) + l * 8, (bf16*)(ws + WS_CML), (float*)(ws + WS_NML), (float*)(ws + WS_SML), wsm, gw, NGW, lane);
            phase_gd_prep(YB, (const bf16*)(ws + WS_KN), (const bf16*)(ws + WS_KNT), (const bf16*)(ws + WS_VNT), GATES, AIN(9) + l * 12, AIN(10) + l * 12,
                          GDB, (bf16*)(ws + WS_WF), (bf16*)(ws + WS_ATT), (float*)(ws + WS_GST), wscr, wsm, gw, NGW, lane);
            __syncthreads();
            SEAM(pb + 2);
        }
        if (IN(pb + 3)) { PH_LOCALS();
            phase_gd_recur(YB, (const bf16*)(ws + WS_KNT), GDB, (const bf16*)(ws + WS_WF), (const bf16*)(ws + WS_ATT), (const float*)(ws + WS_GST), (bf16*)(ws + WS_VNT), lds, bid, G, tid);
            if (G > NCHAIN_GD) { if (bid >= NCHAIN_GD) phase_ml2((bf16*)(ws + WS_CML), (float*)(ws + WS_NML), (float*)(ws + WS_SML), (bid - NCHAIN_GD) * NWAVES * 64 + tid, (G - NCHAIN_GD) * NWAVES * 64); }
            else phase_ml2((bf16*)(ws + WS_CML), (float*)(ws + WS_NML), (float*)(ws + WS_SML), bid * NWAVES * 64 + tid, G * NWAVES * 64);
            if (!MK_SPLIT && G > NCHAIN_GD && bid >= NCHAIN_GD) {
                SUB_BAR(l, G - NCHAIN_GD);
                phase_ml3(MLB, GATES, AIN(5) + l * 8, AIN(6) + l * 8, AIN(7) + l * 256, (const bf16*)(ws + WS_CML), (const float*)(ws + WS_NML), (const float*)(ws + WS_SML), YB, wscr, wsm, (bid - NCHAIN_GD) * NWAVES + wave, (G - NCHAIN_GD) * NWAVES, lane); }
            if (l == 0) { __syncthreads(); if (G > NCHAIN_GD) { if (bid >= NCHAIN_GD) KV_GEMMS(G - NCHAIN_GD, bid - NCHAIN_GD); } else KV_GEMMS(G, bid); }
            else if (!MK_SPLIT && G > NCHAIN_GD && bid >= NCHAIN_GD) { __syncthreads(); ABS_GEMMS(l, G - NCHAIN_GD, bid - NCHAIN_GD); }
            __syncthreads();
            SEAM(pb + 3);
        }
        if (IN(pb + 4)) { PH_LOCALS();
            if (MK_SPLIT || G <= NCHAIN_GD) phase_ml3(MLB, GATES, AIN(5) + l * 8, AIN(6) + l * 8, AIN(7) + l * 256, (bf16*)(ws + WS_CML), (const float*)(ws + WS_NML), (const float*)(ws + WS_SML), YB, wscr, wsm, gw, NGW, lane);
            phase_gd_final(GDB, (const bf16*)(ws + WS_VNT), AIN(11) + l * 384, YB, wscr, gw, NGW, lane);
            __syncthreads();
            if (l == 0) ABS_GEMMS(0, G, bid);
            if (l > 0 && (MK_SPLIT || G <= NCHAIN_GD)) ABS_GEMMS(l, G, bid);
            SEAM(pb + 4);
        }
        if (IN(pb + 5)) { PH_LOCALS();
            pg8::Gemm g{YB, (const bf16*)(ws + WS_WOUT) + (size_t)l * D * D, T, D, D}; pg8::StaticOrder S; S.init(T, D, G, bid); S.wv = wave_s;
            pg8::EpiResid E{XY, D, (float*)(ws + WS_RSS), (LAS unsigned char*)(lds + STG_OFF), (LAS float*)(lds + RING_BYTES)};
            pg8::gemm_phase<pg8::EpiResid, pg8::StaticOrder, true, true>(lds, g, S, E);
            SEAM2(pb + 5);
        }
        if (IN(pb + 7)) { PH_LOCALS();
            pg8::Gemm g{XY, (const bf16*)(absb + ABS_MT) + (size_t)l * BATCH * D * D, T, D, D}; pg8::StaticOrder S; S.init(T, D, G, bid); S.wv = wave_s; S.bmode = 1; S.bdiv = SEQ / 256;
            pg8::EpiSoftmax E{YB, (const float*)(ws + WS_RSS), (LAS float*)(lds + RING_BYTES), (LAS unsigned char*)(lds + STG_OFF)};
            pg8::gemm_phase<pg8::EpiSoftmax, pg8::StaticOrder, true, true>(lds, g, S, E);
            SEAM2(pb + 7);
        }
        if (IN(pb + 9)) { PH_LOCALS();
            pg8::Gemm g{YB, (const bf16*)(absb + ABS_NT) + (size_t)l * BATCH * D * D, T, D, D}; pg8::StaticOrder S; S.init(T, D, G, bid); S.wv = wave_s; S.bmode = 1; S.bdiv = SEQ / 256;
            pg8::EpiResid E{XY, D, (float*)(ws + WS_RSS), (LAS unsigned char*)(lds + STG_OFF), (LAS float*)(lds + RING_BYTES)};
            pg8::gemm_phase<pg8::EpiResid, pg8::StaticOrder, true, true>(lds, g, S, E);
            SEAM2(pb + 9);
        }
        if (IN(pb + 11)) { PH_LOCALS();
            pg8::Gemm g{XY, (const bf16*)(ws + WS_W1) + (size_t)l * FF * D, T, FF, D}; pg8::StaticOrder S; S.init(T, FF, G, bid); S.wv = wave_s;
            pg8::EpiBf16<1> E{(bf16*)(ws + WS_H), FF, (const float*)(ws + WS_RSS), nullptr, (LAS unsigned char*)(lds + STG_OFF)};
            pg8::gemm_phase<pg8::EpiBf16<1>, pg8::StaticOrder, true, true>(lds, g, S, E);
            SEAM(pb + 11);
        }
        if (IN(pb + 12)) { PH_LOCALS();
            pg8::Gemm g{(const bf16*)(ws + WS_H), (const bf16*)(ws + WS_W2) + (size_t)l * D * FF, T, D, FF}; pg8::StaticOrder S; S.init(T, D, G, bid); S.wv = wave_s;
            pg8::EpiResid E{XY, D, (float*)(ws + WS_RSS), (LAS unsigned char*)(lds + STG_OFF), (LAS float*)(lds + RING_BYTES)};
            pg8::gemm_phase<pg8::EpiResid, pg8::StaticOrder, true, true>(lds, g, S, E);
            if (l + 1 == DEPTH) SEAM(pb + 12); else SEAM2(pb + 12);
        }
        if (IN(pb + 13) && l + 1 == DEPTH) { PH_LOCALS();
            for (int m = 2 * gw; m < T; m += 2 * NGW) {
                u32x2 t[2][4];
#pragma unroll
                for (int r = 0; r < 2; ++r) { const u32x2* xr = (const u32x2*)(XY + (size_t)(m + r) * D) + lane;
#pragma unroll
                    for (int j = 0; j < 4; ++j) t[r][j] = xr[64 * j]; }
#pragma unroll
                for (int r = 0; r < 2; ++r) { f32x4 v[4]; float s = 0.f; const f32x4* wr = (const f32x4*)AIN(21) + lane;
#pragma unroll
                    for (int j = 0; j < 4; ++j) { v[j] = (f32x4){bflo(t[r][j].x), bfhi(t[r][j].x), bflo(t[r][j].y), bfhi(t[r][j].y)}; s += (v[j][0] * v[j][0] + v[j][1] * v[j][1]) + (v[j][2] * v[j][2] + v[j][3] * v[j][3]); }
                    const float rstd = 1.f / sqrtf(wave_sum(s) * (1.f / D) + EPS); f32x4* o = (f32x4*)(xo + (size_t)(m + r) * D) + lane;
#pragma unroll
                    for (int j = 0; j < 4; ++j) o[64 * j] = v[j] * rstd * wr[64 * j]; } }
        }
    }
#undef IN
#undef SEAM
}

#ifndef EMU
extern "C" void kernel_launch(void* const* d_in, const int* in_sizes, int n_in, void* d_out, int out_size, void* d_ws, size_t ws_size, hipStream_t stream) {
    static int grid = 0;
    if (grid == 0) {
        if (n_in != 22 || in_sizes[0] != T * D || out_size != T * D || ws_size < WS_END) { fprintf(stderr, "kernel_launch: shape/workspace mismatch (n_in %d, in0 %d, out %d, ws %zu, need %zu)\n", n_in, n_in > 0 ? in_sizes[0] : -1, out_size, ws_size, (size_t)WS_END); grid = -1; return; }
        int dev = 0, cus = 0, per_cu = 0;
        if (hipGetDevice(&dev) != hipSuccess || hipDeviceGetAttribute(&cus, hipDeviceAttributeMultiprocessorCount, dev) != hipSuccess) { grid = -1; return; }
        if (hipFuncSetAttribute((const void*)fwd_kernel, hipFuncAttributeMaxDynamicSharedMemorySize, LDS_BYTES) != hipSuccess) { fprintf(stderr, "kernel_launch: hipFuncSetAttribute failed\n"); grid = -1; return; }
        if (hipOccupancyMaxActiveBlocksPerMultiprocessor(&per_cu, (const void*)fwd_kernel, NWAVES * 64, LDS_BYTES) != hipSuccess || per_cu < 1) { fprintf(stderr, "kernel_launch: occupancy query reports %d\n", per_cu); }
        (void)hipGetLastError();
        grid = cus;
    }
    if (grid < 0) return;
    if (hipMemsetAsync((char*)d_ws + WS_CTL, 0, CTL_ZERO_BYTES, stream) != hipSuccess) return;
    Args a{};
    for (int i = 0; i < 22; ++i) a.in[i] = (const float*)d_in[i];
    a.out = (float*)d_out; a.ws = (unsigned char*)d_ws;
    if (MK_SPLIT) { for (int p = 0; p < NPHASE; ++p) { a.ph_lo = p; a.ph_hi = p + 1; hipLaunchKernelGGL(fwd_kernel, dim3(grid), dim3(NWAVES * 64), LDS_BYTES, stream, a); } }
    else { a.ph_lo = 0; a.ph_hi = NPHASE; hipLaunchKernelGGL(fwd_kernel, dim3(grid), dim3(NWAVES * 64), LDS_BYTES, stream, a); }
}
#endif
```
